# Optimizing an MI355X kernel written in HIP

```python
import jax, jax.numpy as jnp
from jax import lax
import numpy as np

D_MODEL = 4096
BATCH = 4
SEQ = 4096
DEPTH = 1

D_MIX = D_MODEL
RET_HEADS = 8
RET_QK_DIM = 128
RET_V_DIM = 256
MLSTM_HEADS = 4
MLSTM_QK_DIM = 256
MLSTM_V_DIM = 512
CONV_WIDTH = 4
D_FF = 11008
CHUNK = 128
ROPE_BASE = 10000.0
NORM_EPS = 1e-6
FFN_RES_WEIGHT = 0.5

RET_QK_W = RET_HEADS * RET_QK_DIM
RET_V_W = RET_HEADS * RET_V_DIM
MLSTM_QK_W = MLSTM_HEADS * MLSTM_QK_DIM
MLSTM_V_W = MLSTM_HEADS * MLSTM_V_DIM
D_IN_PROJ = 2 * RET_QK_W + 2 * RET_V_W + 2 * MLSTM_QK_W + 2 * MLSTM_V_W + 2 * MLSTM_HEADS

kernel_name = 'hybrid_retention_mlstm_macaron_layer'


def _rmsnorm(x, g):
    xf = x.astype(jnp.float32)
    y = xf * lax.rsqrt(jnp.mean(xf * xf, axis=-1, keepdims=True) + NORM_EPS)
    return (y * g.astype(jnp.float32)).astype(x.dtype)


def _head_rmsnorm(h, g):
    B, S, H, d = h.shape
    return _rmsnorm(h, g.reshape(H, d)).reshape(B, S, H * d)


def _swiglu(h, w_gate, w_up, w_down):
    a = jnp.einsum('bsd,df->bsf', h, w_gate)
    u = jnp.einsum('bsd,df->bsf', h, w_up)
    return jnp.einsum('bsf,fd->bsd', jax.nn.silu(a) * u, w_down)


def _rotary(t):
    S, d = t.shape[1], t.shape[-1]
    half = d // 2
    inv_freq = ROPE_BASE ** (-jnp.arange(half, dtype=jnp.float32) / half)
    ang = jnp.arange(S, dtype=jnp.float32)[:, None] * inv_freq[None, :]
    cos = jnp.cos(ang)[None, :, None, :]
    sin = jnp.sin(ang)[None, :, None, :]
    t1 = t[..., :half].astype(jnp.float32)
    t2 = t[..., half:].astype(jnp.float32)
    return jnp.concatenate([t1 * cos - t2 * sin, t1 * sin + t2 * cos], axis=-1).astype(t.dtype)


def _causal_conv(u, w, b):
    K = w.shape[0]
    S = u.shape[1]
    up = jnp.pad(u, ((0, 0), (K - 1, 0), (0, 0)))
    out = b
    for j in range(K):
        out = out + up[:, j:j + S, :] * w[j]
    return out


def _to_chunks(t):
    B, H, S = t.shape[:3]
    t = t.reshape((B, H, S // CHUNK, CHUNK) + t.shape[3:])
    return jnp.moveaxis(t, 2, 0)


def _from_chunks(t):
    t = jnp.moveaxis(t, 0, 2)
    B, H, nc, C = t.shape[:4]
    return t.reshape((B, H, nc * C) + t.shape[4:])


def _retention_chunkwise(q, k, v):
    B, H, S, dk = q.shape
    dv = v.shape[-1]
    log_gamma = jnp.log1p(-jnp.exp2(-5.0 - jnp.arange(H, dtype=jnp.float32)))
    pos = jnp.arange(CHUNK, dtype=jnp.float32)
    rel = pos[:, None] - pos[None, :]
    intra_decay = jnp.exp(jnp.where(rel >= 0, log_gamma[:, None, None] * rel, -jnp.inf))
    query_decay = jnp.exp(log_gamma[:, None] * (pos + 1.0))[:, :, None]
    key_decay = jnp.exp(log_gamma[:, None] * (CHUNK - 1.0 - pos))[:, :, None]
    chunk_decay = jnp.exp(log_gamma * CHUNK)[:, None, None]

    def step(state, qkv):
        qc, kc, vc = qkv
        scores = jnp.einsum('bhid,bhjd->bhij', qc, kc) * intra_decay
        out = (jnp.einsum('bhij,bhjv->bhiv', scores, vc)
               + jnp.einsum('bhid,bhdv->bhiv', qc, state) * query_decay)
        state = state * chunk_decay + jnp.einsum('bhjd,bhjv->bhdv', kc * key_decay, vc)
        return state, out

    state0 = jnp.zeros((B, H, dk, dv), jnp.float32)
    _, out = lax.scan(step, state0, (_to_chunks(q), _to_chunks(k), _to_chunks(v)))
    return _from_chunks(out).astype(v.dtype)


def _mlstm_chunkwise(q, k, v, i_pre, log_f):
    B, H, S, dk = q.shape
    dv = v.shape[-1]
    causal = jnp.tril(jnp.ones((CHUNK, CHUNK), dtype=bool))

    def step(carry, inp):
        c_mat, n_vec, m = carry
        qc, kc, vc, ic, fc = inp
        b = jnp.cumsum(fc, axis=-1)
        d_log = jnp.where(causal, b[..., :, None] - b[..., None, :] + ic[..., None, :], -jnp.inf)
        inter_log = b + m[..., None]
        m_t = jnp.maximum(inter_log, jnp.max(d_log, axis=-1))
        w_inter = jnp.exp(inter_log - m_t)
        w_intra = jnp.exp(d_log - m_t[..., None])
        s = jnp.einsum('bhid,bhjd->bhij', qc, kc) * w_intra
        num = (jnp.einsum('bhij,bhjv->bhiv', s, vc)
               + w_inter[..., None] * jnp.einsum('bhid,bhdv->bhiv', qc, c_mat))
        nq = jnp.sum(s, axis=-1) + w_inter * jnp.einsum('bhid,bhd->bhi', qc, n_vec)
        h = num / jnp.maximum(jnp.abs(nq), jnp.exp(-m_t))[..., None]
        b_last = b[..., -1]
        m_new = m_t[..., -1]
        w_state = jnp.exp(b_last + m - m_new)
        w_key = jnp.exp(b_last[..., None] - b + ic - m_new[..., None])
        c_mat = w_state[..., None, None] * c_mat + jnp.einsum('bhj,bhjd,bhjv->bhdv', w_key, kc, vc)
        n_vec = w_state[..., None] * n_vec + jnp.einsum('bhj,bhjd->bhd', w_key, kc)
        return (c_mat, n_vec, m_new), h

    carry0 = (jnp.zeros((B, H, dk, dv), jnp.float32),
              jnp.zeros((B, H, dk), jnp.float32),
              jnp.zeros((B, H), jnp.float32))
    xs = (_to_chunks(q), _to_chunks(k), _to_chunks(v), _to_chunks(i_pre), _to_chunks(log_f))
    _, out = lax.scan(step, carry0, xs)
    return _from_chunks(out).astype(v.dtype)


def _mixer(h, w_in, conv_w, conv_b, igate_b, fgate_b, ret_head_norm, mlstm_head_norm, w_out):
    B, S, _ = h.shape
    proj = jnp.einsum('bsd,de->bse', h, w_in)
    sizes = [RET_QK_W, RET_QK_W, RET_V_W, RET_V_W,
             MLSTM_QK_W, MLSTM_QK_W, MLSTM_V_W, MLSTM_V_W, MLSTM_HEADS, MLSTM_HEADS]
    idx = np.cumsum(sizes)[:-1].tolist()
    rq, rk, rv, rg, mq, mk, mv, mo, mi, mf = jnp.split(proj, idx, axis=-1)

    rq = _rotary(rq.reshape(B, S, RET_HEADS, RET_QK_DIM))
    rk = _rotary(rk.reshape(B, S, RET_HEADS, RET_QK_DIM)) * (RET_QK_DIM ** -0.5)
    rv = rv.reshape(B, S, RET_HEADS, RET_V_DIM)
    ret = _retention_chunkwise(rq.transpose(0, 2, 1, 3), rk.transpose(0, 2, 1, 3), rv.transpose(0, 2, 1, 3))
    ret = _head_rmsnorm(ret.transpose(0, 2, 1, 3), ret_head_norm) * jax.nn.silu(rg)

    qk = jax.nn.silu(_causal_conv(jnp.concatenate([mq, mk], axis=-1), conv_w, conv_b))
    mq, mk = jnp.split(qk, 2, axis=-1)
    mq = mq.reshape(B, S, MLSTM_HEADS, MLSTM_QK_DIM).transpose(0, 2, 1, 3)
    mk = (mk * (MLSTM_QK_DIM ** -0.5)).reshape(B, S, MLSTM_HEADS, MLSTM_QK_DIM).transpose(0, 2, 1, 3)
    mv = mv.reshape(B, S, MLSTM_HEADS, MLSTM_V_DIM).transpose(0, 2, 1, 3)
    i_pre = (mi + igate_b).astype(jnp.float32).transpose(0, 2, 1)
    log_f = jax.nn.log_sigmoid((mf + fgate_b).astype(jnp.float32)).transpose(0, 2, 1)
    mh = _mlstm_chunkwise(mq, mk, mv, i_pre, log_f)
    mh = _head_rmsnorm(mh.transpose(0, 2, 1, 3), mlstm_head_norm) * jax.nn.sigmoid(mo)

    return jnp.einsum('bse,ed->bsd', jnp.concatenate([ret, mh], axis=-1), w_out)


def setup_inputs(seed: int = 0) -> dict:
    key = jax.random.key(seed)
    ks = jax.random.split(key, 20)
    f32 = jnp.float32
    L = DEPTH

    def nrm(k, shape, scale):
        return jax.random.normal(k, shape, f32) * scale

    def gain(k, shape):
        return 1.0 + 0.02 * jax.random.normal(k, shape, f32)

    return {
        'x': nrm(ks[0], (BATCH, SEQ, D_MODEL), 1.0),
        'ffn1_norm': gain(ks[1], (L, D_MODEL)),
        'ffn1_w_gate': nrm(ks[2], (L, D_MODEL, D_FF), D_MODEL ** -0.5),
        'ffn1_w_up': nrm(ks[3], (L, D_MODEL, D_FF), D_MODEL ** -0.5),
        'ffn1_w_down': nrm(ks[4], (L, D_FF, D_MODEL), D_FF ** -0.5),
        'mix_norm': gain(ks[5], (L, D_MODEL)),
        'w_in': nrm(ks[6], (L, D_MODEL, D_IN_PROJ), D_MODEL ** -0.5),
        'conv_w': nrm(ks[7], (L, CONV_WIDTH, 2 * MLSTM_QK_W), CONV_WIDTH ** -0.5),
        'conv_b': nrm(ks[8], (L, 2 * MLSTM_QK_W), 0.02),
        'igate_b': nrm(ks[9], (L, MLSTM_HEADS), 0.1),
        'fgate_b': jnp.linspace(3.0, 6.0, MLSTM_HEADS, dtype=f32)[None, :] + nrm(ks[10], (L, MLSTM_HEADS), 0.1),
        'ret_head_norm': gain(ks[11], (L, RET_V_W)),
        'mlstm_head_norm': gain(ks[12], (L, MLSTM_V_W)),
        'w_out': nrm(ks[13], (L, D_MIX, D_MODEL), D_MIX ** -0.5),
        'ffn2_norm': gain(ks[14], (L, D_MODEL)),
        'ffn2_w_gate': nrm(ks[15], (L, D_MODEL, D_FF), D_MODEL ** -0.5),
        'ffn2_w_up': nrm(ks[16], (L, D_MODEL, D_FF), D_MODEL ** -0.5),
        'ffn2_w_down': nrm(ks[17], (L, D_FF, D_MODEL), D_FF ** -0.5),
        'final_norm': gain(ks[18], (D_MODEL,)),
    }


def reference(x, ffn1_norm, ffn1_w_gate, ffn1_w_up, ffn1_w_down, mix_norm, w_in, conv_w, conv_b,
              igate_b, fgate_b, ret_head_norm, mlstm_head_norm, w_out, ffn2_norm, ffn2_w_gate,
              ffn2_w_up, ffn2_w_down, final_norm):
    for layer in range(DEPTH):
        x = x + FFN_RES_WEIGHT * _swiglu(_rmsnorm(x, ffn1_norm[layer]),
                                         ffn1_w_gate[layer], ffn1_w_up[layer], ffn1_w_down[layer])
        x = x + _mixer(_rmsnorm(x, mix_norm[layer]), w_in[layer], conv_w[layer], conv_b[layer],
                       igate_b[layer], fgate_b[layer], ret_head_norm[layer], mlstm_head_norm[layer],
                       w_out[layer])
        x = x + FFN_RES_WEIGHT * _swiglu(_rmsnorm(x, ffn2_norm[layer]),
                                         ffn2_w_gate[layer], ffn2_w_up[layer], ffn2_w_down[layer])
    return _rmsnorm(x, final_norm)
```

```cpp
#include <hip/hip_runtime.h>
#include <cstdio>
#include <cstdint>
namespace pg8 {
#define PG8_LAS __attribute__((address_space(3)))
typedef unsigned short bf16_t;
typedef short bf16x8 __attribute__((ext_vector_type(8)));
typedef float f32x4 __attribute__((ext_vector_type(4)));
typedef unsigned u32x4 __attribute__((ext_vector_type(4)));
constexpr int BM = 256, BK = 64, HALF = 128, HTB = HALF * BK * 2  , STAGE_BYTES = 8 * HTB, NXCD = 8, WGM = 8;

__host__ __device__ __forceinline__ int lds_byte(int r, int c) { const int st = (r >> 4) * 2 + (c >> 5), rr = r & 15, cc = c & 31, ob = rr * 64 + cc * 2; return st * 1024 + (ob ^ (((ob >> 9) & 1) << 5)); }
__host__ __device__ __forceinline__ void stage_rc(int b, int& R, int& C) { const int st = b / 1024, sb = b % 1024, swz = sb ^ (((sb >> 9) & 1) << 5); R = (st >> 1) * 16 + swz / 64; C = (st & 1) * 32 + (swz % 64) / 2; }
__host__ __device__ __forceinline__ int perm32(int rho) { const int n = rho >> 4, i = rho & 15; return 8 * (i >> 2) + 4 * n + (i & 3); }

struct Unit { int pm, pn; };
struct Gemm { const bf16_t* A; const bf16_t* Bt; int M, N, K; };

struct StaticOrder {
    int nM, nN, nwg, G, c;
    __host__ __device__ void init(int M, int N, int G_, int c_) { nM = M / BM; nN = N / BM; nwg = nM * nN; G = G_; c = c_; }
    __host__ __device__ bool next(int i, Unit& u) const {
        const long L = (long)i * G + c; if (L >= nwg) return false;
        int wgid = (int)L; { const int q = nwg / NXCD, r = nwg % NXCD, xcd = wgid % NXCD, off = wgid / NXCD; wgid = (xcd < r ? xcd * (q + 1) : r * (q + 1) + (xcd - r) * q) + off; }
        const int nig = WGM * nN, gid = wgid / nig, fm = gid * WGM, gsz = (nM - fm) < WGM ? (nM - fm) : WGM;
        u.pm = fm + ((wgid % nig) % gsz); u.pn = (wgid % nig) / gsz; return true;
    }
    __device__ __forceinline__ void a_ready(const Unit&) const {}
    __device__ __forceinline__ void done(const Unit&) const {}
};


__device__ __forceinline__ unsigned cvt_pk_bf16(float lo, float hi) { unsigned r; asm volatile("v_cvt_pk_bf16_f32 %0, %1, %2" : "=v"(r) : "v"(lo), "v"(hi)); return r; }

struct EpiBf16 {
    static constexpr bool PERM = true, AFTER_DRAIN = false;
    bf16_t* O; int ldc;
    __device__ __forceinline__ void operator()(const f32x4 (&acc)[2][2][4][2], const Unit& u, int wr, int wc, int fr, int fq) const {
        const int row0 = u.pm * BM + wr * 64 + fr, col0 = u.pn * BM + wc * 32 + 8 * fq;
#pragma unroll
        for (int ai = 0; ai < 2; ++ai)
#pragma unroll
            for (int m = 0; m < 4; ++m) { bf16_t* rowp = O + (size_t)(row0 + ai * HALF + m * 16) * ldc + col0;
#pragma unroll
                for (int bj = 0; bj < 2; ++bj) { const f32x4 v0 = acc[ai][bj][m][0], v1 = acc[ai][bj][m][1];
                    u32x4 w; w.x = cvt_pk_bf16(v0[0], v0[1]); w.y = cvt_pk_bf16(v0[2], v0[3]); w.z = cvt_pk_bf16(v1[0], v1[1]); w.w = cvt_pk_bf16(v1[2], v1[3]);
                    *(u32x4*)(rowp + bj * HALF) = w; } }
    }
};
__device__ __forceinline__ float silu_mul(float g, float u) { return g * u * __builtin_amdgcn_rcpf(1.0f + __builtin_amdgcn_exp2f(-1.44269504089f * g)); }
struct EpiSwiGLU {
    static constexpr bool PERM = true, AFTER_DRAIN = false;
    bf16_t* O; int ldc;
    __device__ __forceinline__ void operator()(const f32x4 (&acc)[2][2][4][2], const Unit& u, int wr, int wc, int fr, int fq) const {
        const int row0 = u.pm * BM + wr * 64 + fr, col0 = u.pn * HALF + wc * 32 + 8 * fq;
#pragma unroll
        for (int ai = 0; ai < 2; ++ai)
#pragma unroll
            for (int m = 0; m < 4; ++m) { bf16_t* rowp = O + (size_t)(row0 + ai * HALF + m * 16) * ldc + col0;
                const f32x4 g0 = acc[ai][0][m][0], g1 = acc[ai][0][m][1], u0 = acc[ai][1][m][0], u1 = acc[ai][1][m][1];
                u32x4 w; w.x = cvt_pk_bf16(silu_mul(g0[0], u0[0]), silu_mul(g0[1], u0[1])); w.y = cvt_pk_bf16(silu_mul(g0[2], u0[2]), silu_mul(g0[3], u0[3]));
                w.z = cvt_pk_bf16(silu_mul(g1[0], u1[0]), silu_mul(g1[1], u1[1])); w.w = cvt_pk_bf16(silu_mul(g1[2], u1[2]), silu_mul(g1[3], u1[3]));
                *(u32x4*)rowp = w; }
    }
};
struct EpiResF32 {
    static constexpr bool PERM = false, AFTER_DRAIN = false;
    const float* base; float* out; int ldc; float alpha;
    __device__ __forceinline__ void operator()(const f32x4 (&acc)[2][2][4][2], const Unit& u, int wr, int wc, int fr, int fq) const {
        const int row0 = u.pm * BM + wr * 64 + fr, col0 = u.pn * BM + wc * 32 + 4 * fq;
#pragma unroll
        for (int ai = 0; ai < 2; ++ai)
#pragma unroll
            for (int m = 0; m < 4; ++m) { const size_t off = (size_t)(row0 + ai * HALF + m * 16) * ldc + col0;
#pragma unroll
                for (int bj = 0; bj < 2; ++bj)
#pragma unroll
                    for (int n = 0; n < 2; ++n) { const f32x4 bs = *(const f32x4*)(base + off + bj * HALF + n * 16); *(f32x4*)(out + off + bj * HALF + n * 16) = bs + alpha * acc[ai][bj][m][n]; }
                asm volatile("" ::: "memory"); }
    }
};

template <class Epi, class Sched, bool ALIGN_EPI = false, bool SP2 = false>
__device__ __forceinline__ void gemm_phase(PG8_LAS unsigned char* lds, const Gemm g, const Sched& S, const Epi& E) {
    const int tid = threadIdx.x, wid = __builtin_amdgcn_readfirstlane(tid >> 6), lane = tid & 63, wr = wid >> 2, wc = wid & 3, fr = lane & 15, fq = lane >> 4;
    const int K = g.K, nt = K / BK;
    unsigned voffA[2], voffB[2];
#pragma unroll
    for (int i = 0; i < 2; ++i) { int R, C; stage_rc(tid * 16 + i * 8192, R, C); const int Rb = Epi::PERM ? ((R & ~31) + perm32(R & 31)) : R;
        voffA[i] = (unsigned)(R * K + C) * 2u; voffB[i] = (unsigned)(Rb * K + C) * 2u; }
    const size_t kstep = (size_t)(BK * 2);
    const size_t hstep = (size_t)HALF * K * 2;
    const size_t tstep = 2 * hstep;
    const unsigned ldsw = (unsigned)wid * 1024u;
    const int aoff = lds_byte(wr * 64 + fr, fq * 8), boff = lds_byte(wc * 32 + fr, fq * 8);
#define PG8_SA(b, h) (((b) * 2 + (h)) * HTB)
#define PG8_SB(b, h) ((4 + (b) * 2 + (h)) * HTB)
#define PG8_STAGE(bufoff, gbase, voff) do { _Pragma("unroll") for (int _i = 0; _i < 2; ++_i) \
        __builtin_amdgcn_global_load_lds((const unsigned*)((const char*)(gbase) + (voff)[_i]), (PG8_LAS unsigned*)(lds + (bufoff) + ldsw + _i * 8192), 16, 0, 0); } while (0)
#define PG8_LDA(dst, b, h) do { _Pragma("unroll") for (int m = 0; m < 4; ++m) _Pragma("unroll") for (int k = 0; k < 2; ++k) dst[m][k] = *(const PG8_LAS bf16x8*)(lds + PG8_SA(b, h) + aoff + m * 2048 + k * 1024); } while (0)
#define PG8_LDB(dst, b, h) do { _Pragma("unroll") for (int n = 0; n < 2; ++n) _Pragma("unroll") for (int k = 0; k < 2; ++k) dst[n][k] = *(const PG8_LAS bf16x8*)(lds + PG8_SB(b, h) + boff + n * 2048 + k * 1024); } while (0)
#define PG8_MMA(ai, bj, At, Bt) do { __builtin_amdgcn_s_setprio(1); _Pragma("unroll") for (int m = 0; m < 4; ++m) _Pragma("unroll") for (int n = 0; n < 2; ++n) _Pragma("unroll") for (int k = 0; k < 2; ++k) \
        acc[ai][bj][m][n] = __builtin_amdgcn_mfma_f32_16x16x32_bf16(Bt[n][k], At[m][k], acc[ai][bj][m][n], 0, 0, 0); __builtin_amdgcn_s_setprio(0); } while (0)
#define PG8_WAIT_V(n) asm volatile("s_waitcnt vmcnt(" #n ")" ::: "memory")
#define PG8_WAIT_L(n) asm volatile("s_waitcnt lgkmcnt(" #n ")" ::: "memory")
#define PG8_BAR __builtin_amdgcn_s_barrier()
#define PG8_SCHED __builtin_amdgcn_sched_barrier(0)
    Unit cur, nxt; int ui = 0;
    if (!S.next(0, cur)) return;
    f32x4 acc[2][2][4][2];
#pragma unroll
    for (int a = 0; a < 2; ++a)
#pragma unroll
        for (int b = 0; b < 2; ++b)
#pragma unroll
            for (int m = 0; m < 4; ++m)
#pragma unroll
                for (int n = 0; n < 2; ++n) acc[a][b][m][n] = (f32x4){0.f, 0.f, 0.f, 0.f};
    bf16x8 At[4][2], B0[2][2], B1[2][2];
    const char* cA = (const char*)g.A + (size_t)cur.pm * tstep; const char* cB = (const char*)g.Bt + (size_t)cur.pn * tstep;
    S.a_ready(cur);
    if constexpr (SP2) {
        PG8_STAGE(PG8_SB(0, 0), cB, voffB); PG8_STAGE(PG8_SB(0, 1), cB + hstep, voffB); PG8_STAGE(PG8_SA(0, 0), cA, voffA); PG8_STAGE(PG8_SA(0, 1), cA + hstep, voffA);
        if (wr == 1) PG8_BAR;
        PG8_WAIT_V(2); PG8_BAR;
        PG8_STAGE(PG8_SB(1, 0), cB + kstep, voffB); PG8_STAGE(PG8_SA(1, 0), cA + kstep, voffA); PG8_STAGE(PG8_SB(1, 1), cB + hstep + kstep, voffB);
        PG8_WAIT_V(6); PG8_BAR;
    } else {
        PG8_STAGE(PG8_SB(0, 0), cB, voffB); PG8_STAGE(PG8_SA(0, 0), cA, voffA); PG8_STAGE(PG8_SB(0, 1), cB + hstep, voffB); PG8_STAGE(PG8_SA(0, 1), cA + hstep, voffA);
        if (wr == 1) PG8_BAR;
        PG8_WAIT_V(4); PG8_BAR;
        PG8_STAGE(PG8_SB(1, 0), cB + kstep, voffB); PG8_STAGE(PG8_SA(1, 0), cA + kstep, voffA); PG8_STAGE(PG8_SB(1, 1), cB + hstep + kstep, voffB);
        PG8_WAIT_V(6); PG8_BAR;
    }
    for (;;) {
        const bool has_next = S.next(ui + 1, nxt);
        const char* nA = has_next ? (const char*)g.A + (size_t)nxt.pm * tstep : cA; const char* nB = has_next ? (const char*)g.Bt + (size_t)nxt.pn * tstep : cB;
        for (int t = 0; t < nt; t += 2) {
            const bool last = (t == nt - 2);
            const char* a1 = cA + (size_t)(t + 1) * kstep;
            const char* a2 = last ? nA : cA + (size_t)(t + 2) * kstep; const char* b2 = last ? nB : cB + (size_t)(t + 2) * kstep;
            const char* a3 = a2 + kstep; const char* b3 = b2 + kstep;
            if (last && has_next) S.a_ready(nxt);
            if constexpr (SP2) {
            PG8_LDB(B0, 0, 0); PG8_LDB(B1, 0, 1); PG8_SCHED; PG8_LDA(At, 0, 0); PG8_STAGE(PG8_SA(1, 1), a1 + hstep, voffA);
            PG8_WAIT_V(8); PG8_WAIT_L(0); PG8_BAR; PG8_MMA(0, 0, At, B0); PG8_MMA(0, 1, At, B1); PG8_BAR; PG8_SCHED;
            PG8_LDA(At, 0, 1); PG8_STAGE(PG8_SB(0, 0), b2, voffB); PG8_STAGE(PG8_SB(0, 1), b2 + hstep, voffB); PG8_STAGE(PG8_SA(0, 0), a2, voffA);
            PG8_WAIT_V(8); PG8_WAIT_L(0); PG8_BAR; PG8_MMA(1, 0, At, B0); PG8_MMA(1, 1, At, B1); PG8_BAR; PG8_SCHED;
            PG8_LDB(B0, 1, 0); PG8_LDB(B1, 1, 1); PG8_SCHED; PG8_LDA(At, 1, 0); PG8_STAGE(PG8_SA(0, 1), a2 + hstep, voffA);
            PG8_WAIT_V(8); PG8_WAIT_L(0); PG8_BAR; PG8_MMA(0, 0, At, B0); PG8_MMA(0, 1, At, B1); PG8_BAR; PG8_SCHED;
            PG8_LDA(At, 1, 1); PG8_STAGE(PG8_SB(1, 0), b3, voffB); PG8_STAGE(PG8_SB(1, 1), b3 + hstep, voffB); PG8_STAGE(PG8_SA(1, 0), a3, voffA);
            PG8_WAIT_V(8); PG8_WAIT_L(0); PG8_BAR; PG8_MMA(1, 0, At, B0); PG8_MMA(1, 1, At, B1); PG8_BAR; PG8_SCHED;
            } else {
            PG8_LDB(B0, 0, 0); PG8_SCHED; PG8_LDA(At, 0, 0); PG8_STAGE(PG8_SA(1, 1), a1 + hstep, voffA);
            PG8_WAIT_L(8); PG8_BAR; PG8_WAIT_L(0); PG8_MMA(0, 0, At, B0); PG8_BAR; PG8_SCHED;
            PG8_LDB(B1, 0, 1); PG8_STAGE(PG8_SB(0, 0), b2, voffB);
            PG8_BAR; PG8_WAIT_L(0); PG8_MMA(0, 1, At, B1); PG8_BAR;
            PG8_LDA(At, 0, 1); PG8_STAGE(PG8_SA(0, 0), a2, voffA);
            PG8_BAR; PG8_WAIT_L(0); PG8_MMA(1, 0, At, B0); PG8_BAR; PG8_SCHED;
            PG8_STAGE(PG8_SB(0, 1), b2 + hstep, voffB);
            PG8_WAIT_V(6); PG8_BAR; PG8_MMA(1, 1, At, B1); PG8_BAR;
            PG8_LDB(B0, 1, 0); PG8_SCHED; PG8_LDA(At, 1, 0); PG8_STAGE(PG8_SA(0, 1), a2 + hstep, voffA);
            PG8_WAIT_L(8); PG8_BAR; PG8_WAIT_L(0); PG8_MMA(0, 0, At, B0); PG8_BAR; PG8_SCHED;
            PG8_LDB(B1, 1, 1); PG8_STAGE(PG8_SB(1, 0), b3, voffB);
            PG8_BAR; PG8_WAIT_L(0); PG8_MMA(0, 1, At, B1); PG8_BAR;
            PG8_LDA(At, 1, 1); PG8_STAGE(PG8_SA(1, 0), a3, voffA);
            PG8_BAR; PG8_WAIT_L(0); PG8_MMA(1, 0, At, B0); PG8_BAR; PG8_SCHED;
            PG8_STAGE(PG8_SB(1, 1), b3 + hstep, voffB);
            PG8_WAIT_V(6); PG8_BAR; PG8_MMA(1, 1, At, B1); PG8_BAR;
            }
        }
        if constexpr (ALIGN_EPI) { if (wr == 0) PG8_BAR; }
        if constexpr (!Epi::AFTER_DRAIN) { E(acc, cur, wr, wc, fr, fq); S.done(cur); }
        if (!has_next) break;
#pragma unroll
        for (int a = 0; a < 2; ++a)
#pragma unroll
            for (int b = 0; b < 2; ++b)
#pragma unroll
                for (int m = 0; m < 4; ++m)
#pragma unroll
                    for (int n = 0; n < 2; ++n) acc[a][b][m][n] = (f32x4){0.f, 0.f, 0.f, 0.f};
        cur = nxt; cA = nA; cB = nB; ++ui;
        if constexpr (ALIGN_EPI) { if (wr == 1) PG8_BAR; }
    }
    PG8_WAIT_V(0);
    if constexpr (!ALIGN_EPI) { if (wr == 0) PG8_BAR; }
    PG8_BAR;
    if constexpr (Epi::AFTER_DRAIN) { E.fused(acc, cur, wr, wc, fr, fq, lds, wid, lane); S.done(cur); }
#undef PG8_SA
#undef PG8_SB
#undef PG8_STAGE
#undef PG8_LDA
#undef PG8_LDB
#undef PG8_MMA
#undef PG8_WAIT_V
#undef PG8_WAIT_L
#undef PG8_BAR
#undef PG8_SCHED
}
}

#define GAS __attribute__((address_space(1)))
#define LAS __attribute__((address_space(3)))
typedef unsigned short bf16;
typedef unsigned v4u __attribute__((ext_vector_type(4)));
typedef float f32x4 __attribute__((ext_vector_type(4)));
typedef short bf16x8 __attribute__((ext_vector_type(8)));
typedef GAS unsigned gu32;
typedef GAS unsigned long long gu64;
#define RLX_AGENT __ATOMIC_RELAXED, __HIP_MEMORY_SCOPE_AGENT
#define LDS_WAIT() asm volatile("s_waitcnt lgkmcnt(0)" ::: "memory")
#define VM_WAIT() asm volatile("s_waitcnt vmcnt(0)" ::: "memory")
__device__ __forceinline__ unsigned long long rt() { return __builtin_amdgcn_s_memrealtime(); }
__device__ __forceinline__ unsigned f2bf(float f) { unsigned u = __builtin_bit_cast(unsigned, f); return (u + 0x7fffu + ((u >> 16) & 1u)) >> 16; }
__device__ __forceinline__ unsigned pk2(float lo, float hi) { return f2bf(lo) | (f2bf(hi) << 16); }

#define XB_TMO      128
#define XB_XCNT(j)  (256  + 64 * (j))
#define XB_XSUB(j)  (1280 + 64 * (j))
#define XB_XGEN(j)  (2304 + 64 * (j))
#define XB_TOP      3328
#define XB_TOPGEN   3392
#define XCD_BAR_WORDS 3456
#define XB_SPIN_CAP (1u << 18)

__device__ __forceinline__ unsigned xb_ld(unsigned* p)              { return __hip_atomic_load(p, __ATOMIC_RELAXED, __HIP_MEMORY_SCOPE_AGENT); }
__device__ __forceinline__ unsigned xb_add(unsigned* p, unsigned v) { return __hip_atomic_fetch_add(p, v, __ATOMIC_RELAXED, __HIP_MEMORY_SCOPE_AGENT); }
__device__ __forceinline__ unsigned xb_xcc_id() { return (unsigned)__builtin_amdgcn_s_getreg((3 << 11) | 20) & 0xFu; }
#define XB_SPIN(cond, bar) do { unsigned _sp = 0; while (cond) { __builtin_amdgcn_s_sleep(1); \
    if ((++_sp & 255u) == 0u) { if (xb_ld(&(bar)[XB_TMO])) break; if (_sp > XB_SPIN_CAP) { atomicAdd(&(bar)[XB_TMO], 1u); break; } } } } while (0)

struct XcdBarrier {
    unsigned* bar; unsigned x;
    volatile LAS unsigned* st;
};

__device__ __forceinline__ XcdBarrier xcd_barrier_post(unsigned* bar, volatile LAS unsigned* st) {
    XcdBarrier b; b.bar = bar; b.x = xb_xcc_id(); b.st = st;
    if (threadIdx.x == 0) (void)xb_add(&bar[XB_XCNT(b.x)], 1u);
    return b;
}
__device__ __forceinline__ void xcd_barrier_complete(unsigned* bar, unsigned x, unsigned& nloc, unsigned& nx) {
    const unsigned G = gridDim.x * gridDim.y * gridDim.z;
    unsigned sum, cnt, mine, sp = 0u;
    for (;;) {
        sum = 0u; cnt = 0u; mine = 0u;
#pragma unroll
        for (unsigned j = 0; j < 16; ++j) { const unsigned c = xb_ld(&bar[XB_XCNT(j)]); sum += c; cnt += (c > 0u) ? 1u : 0u; mine = (j == x) ? c : mine; }
        if (sum == G) break;
        __builtin_amdgcn_s_sleep(1);
        if ((++sp & 255u) == 0u) { if (xb_ld(&bar[XB_TMO])) break; if (sp > XB_SPIN_CAP) { atomicAdd(&bar[XB_TMO], 1u); break; } }
    }
    nloc = mine > 0u ? mine : 1u; nx = cnt > 0u ? cnt : 1u;
}

__device__ __forceinline__ void xcd_barrier(const XcdBarrier& b) {
    asm volatile("s_waitcnt vmcnt(0)" ::: "memory");
    __syncthreads();
    if (threadIdx.x == 0) {
        unsigned* bar = b.bar;
        __builtin_amdgcn_s_waitcnt(0);
        unsigned nloc = b.st[0], nx = b.st[1];
        if (nloc == 0u) { xcd_barrier_complete(bar, b.x, nloc, nx); b.st[0] = nloc; b.st[1] = nx; }
        const unsigned old = xb_add(&bar[XB_XSUB(b.x)], 1u);
        const unsigned gen = old / nloc;
        if (old + 1u == (gen + 1u) * nloc) {
            __builtin_amdgcn_fence(__ATOMIC_RELEASE, "agent");
            asm volatile("s_waitcnt vmcnt(0)" ::: "memory");
            const unsigned og = xb_add(&bar[XB_TOP], 1u);
            const unsigned tg = og / nx;
            if (og + 1u == (tg + 1u) * nx) xb_add(&bar[XB_TOPGEN], 1u);
            else XB_SPIN(xb_ld(&bar[XB_TOPGEN]) == tg, bar);
            __builtin_amdgcn_fence(__ATOMIC_ACQUIRE, "agent");
            xb_add(&bar[XB_XGEN(b.x)], 1u);
            asm volatile("s_waitcnt vmcnt(0)" ::: "memory");
        } else {
            XB_SPIN(xb_ld(&bar[XB_XGEN(b.x)]) == gen, bar);
            __builtin_amdgcn_fence(__ATOMIC_ACQUIRE, "agent");
            asm volatile("s_waitcnt vmcnt(0)" ::: "memory");
        }
    }
    __syncthreads();
}

__device__ const double INV_FREQ[64] = {1.0, 0.8659643233600653, 0.7498942093324559, 0.6493816315762113, 0.5623413251903491, 0.4869675251658631, 0.4216965034285822, 0.3651741272548377, 0.31622776601683794, 0.27384196342643613, 0.23713737056616552, 0.2053525026457146, 0.1778279410038923, 0.1539926526059492, 0.1333521432163324, 0.11547819846894582, 0.1, 0.08659643233600653, 0.07498942093324558, 0.06493816315762113, 0.05623413251903491, 0.04869675251658631, 0.042169650342858224, 0.03651741272548377, 0.03162277660168379, 0.027384196342643614, 0.023713737056616554, 0.02053525026457146, 0.01778279410038923, 0.01539926526059492, 0.01333521432163324, 0.011547819846894581, 0.01, 0.008659643233600654, 0.007498942093324558, 0.006493816315762113, 0.005623413251903491, 0.004869675251658631, 0.004216965034285823, 0.003651741272548377, 0.0031622776601683794, 0.0027384196342643613, 0.0023713737056616554, 0.002053525026457146, 0.0017782794100389228, 0.001539926526059492, 0.001333521432163324, 0.0011547819846894581, 0.001, 0.0008659643233600654, 0.0007498942093324559, 0.0006493816315762113, 0.0005623413251903491, 0.0004869675251658631, 0.00042169650342858224, 0.0003651741272548377, 0.00031622776601683794, 0.0002738419634264361, 0.00023713737056616554, 0.0002053525026457146, 0.00017782794100389227, 0.0001539926526059492, 0.0001333521432163324, 0.00011547819846894582};
#define PG8_SP2 true
#define PG8_ALIGN true
constexpr int NWAVES = 8;
constexpr int BATCH = 4, SEQ = 4096, D = 4096, FF = 11008, M = BATCH * SEQ, NPROJ = 12288, NPROJ_ALL = 12296, CH = 128, NCH = SEQ / CH;
constexpr int RH = 8, RDK = 128, RDV = 256, MH = 4, MDK = 256, MDV = 512, MVR = 528  ;
constexpr float NORM_EPS = 1e-6f;
constexpr int C_RQ = 0, C_RK = 1024, C_RV = 2048, C_RG = 4096, C_MQ = 6144, C_MK = 7168, C_MV = 8192, C_MO = 10240;
constexpr size_t MiB = 1u << 20;
constexpr size_t WS_CTL = 0, CTL_ZERO_BYTES = 1 * MiB;
constexpr size_t WS_ROT = 1 * MiB;
constexpr size_t WS_GI = 3 * MiB;
constexpr size_t WS_LF = WS_GI + 256 * 1024;
constexpr size_t WS_WG8 = WS_LF + 256 * 1024;
constexpr size_t WS_CHS = WS_WG8 + 128 * 1024;
constexpr size_t WS_MP = WS_CHS + 4096;
constexpr size_t WS_ST_R = 8 * MiB;
constexpr size_t WS_ST_M = 72 * MiB;
constexpr size_t WS_WGU1 = 8 * MiB;
constexpr size_t WS_WD1 = 180 * MiB;
constexpr size_t WS_WIN = 266 * MiB;
constexpr size_t WS_WOUT = 362 * MiB;
constexpr size_t WS_WGU2 = 394 * MiB;
constexpr size_t WS_WD2 = 566 * MiB;
constexpr size_t WS_XN = 652 * MiB;
constexpr size_t WS_BIG = 780 * MiB;
constexpr size_t WS_END = 1164 * MiB;
static_assert(WS_ST_M + (size_t)16 * 32 * MVR * MDK * 2 <= WS_WIN && WS_ST_R + (size_t)32 * 32 * RDV * RDK * 2 <= WS_ST_M, "state overlay");
static_assert(WS_BIG + (size_t)M * NPROJ * 2 <= WS_END, "ws map");
constexpr int CW_BAR = 4096;
constexpr int RING_OFF = 0, RING_BYTES = 131072;
constexpr int SM_OFF = 139264;
constexpr int LDSCTL_OFF = 141312, MISC_OFF = LDSCTL_OFF + 320;
constexpr int LDS_BYTES = 147456;
static_assert(MISC_OFF + 128 <= LDS_BYTES, "LDS map");

typedef short s16x4 __attribute__((ext_vector_type(4)));
typedef float f32x2 __attribute__((ext_vector_type(2)));
typedef unsigned v2u __attribute__((ext_vector_type(2)));
struct Frame {
    LAS unsigned char* lds;
    volatile LAS unsigned* MISC;
    gu32* ctl;
    int tid, lane, wave;
    int vcu, G;
    const float* in[19]; float* out; unsigned char* ws;
};
__device__ __forceinline__ float wave_sum(float v) {
#pragma unroll
    for (int o = 1; o < 64; o <<= 1) v += __shfl_xor(v, o);
    return v;
}
__device__ __forceinline__ float bf2f(short s) { return __builtin_bit_cast(float, ((unsigned)(unsigned short)s) << 16); }
__device__ __forceinline__ float bflo(unsigned w) { return __builtin_bit_cast(float, w << 16); }
__device__ __forceinline__ float bfhi(unsigned w) { return __builtin_bit_cast(float, w & 0xffff0000u); }

__device__ __forceinline__ void transpose_item(const float* W, int ldw, int k0, int n0, bf16* WT, int K, LAS float* scr, int lane) {
    f32x4 v[8];
#pragma unroll
    for (int i = 0; i < 8; ++i) { const int kk = 8 * i + (lane >> 3); v[i] = *(const GAS f32x4*)(W + (size_t)(k0 + kk) * ldw + n0 + 4 * (lane & 7)); }
#pragma unroll
    for (int i = 0; i < 8; ++i) { const int kk = 8 * i + (lane >> 3); LAS float* p = scr + kk * 33 + 4 * (lane & 7); p[0] = v[i].x; p[1] = v[i].y; p[2] = v[i].z; p[3] = v[i].w; }
    LDS_WAIT(); asm volatile("" ::: "memory");
    const int c = lane & 7;
#pragma unroll
    for (int j = 0; j < 4; ++j) { const int n = (lane >> 3) + 8 * j; const LAS float* s = scr + (8 * c) * 33 + n;
        v4u o; o.x = pk2(s[0 * 33], s[1 * 33]); o.y = pk2(s[2 * 33], s[3 * 33]); o.z = pk2(s[4 * 33], s[5 * 33]); o.w = pk2(s[6 * 33], s[7 * 33]);
        *(GAS v4u*)(WT + (size_t)n * K + k0 + 8 * c) = o; }
    LDS_WAIT(); asm volatile("" ::: "memory");
}
__device__ __forceinline__ void transpose_plain(const float* W, int K, int N, int ldw, bf16* WT, LAS float* scr, int item, int lane) {
    const int nblk = N / 32, kb = item / nblk, nb = item % nblk;
    transpose_item(W, ldw, 64 * kb, 32 * nb, WT + (size_t)(32 * nb) * K, K, scr, lane);
}
__device__ __forceinline__ void transpose_gu(const float* W, int half, bf16* WT, LAS float* scr, int item, int lane) {
    const int nblk = FF / 32, kb = item / nblk, nb = item % nblk, n0 = 32 * nb;
    transpose_item(W, FF, 64 * kb, n0, WT + (size_t)((n0 >> 7) * 256 + half * 128 + (n0 & 127)) * D, D, scr, lane);
}
template <int MODE>
__device__ __forceinline__ void norm_row(const float* xrow, const float* g, bf16* orow, float* frow, const LAS float* wg, float (&gd)[8], int lane) {
    const GAS f32x4* xr = (const GAS f32x4*)xrow + lane; const GAS f32x4* gr = (const GAS f32x4*)g + lane;
    f32x4 v[16]; float s = 0.f;
#pragma unroll
    for (int j = 0; j < 16; ++j) { v[j] = xr[64 * j]; s += (v[j].x * v[j].x + v[j].y * v[j].y) + (v[j].z * v[j].z + v[j].w * v[j].w); }
    const float rstd = 1.0f / sqrtf(wave_sum(s) * (1.0f / D) + NORM_EPS);
#pragma unroll
    for (int hh = 0; hh < 8; ++hh) gd[hh] = 0.f;
#pragma unroll
    for (int j = 0; j < 16; ++j) {
        const f32x4 gv = gr[64 * j]; const f32x4 y = v[j] * rstd * gv;
        if (MODE == 2) { ((GAS f32x4*)frow + lane)[64 * j] = y; }
        else { v2u o; o.x = pk2(y.x, y.y); o.y = pk2(y.z, y.w); ((GAS v2u*)orow + lane)[64 * j] = o; }
        if (MODE == 1) {
#pragma unroll
            for (int hh = 0; hh < 8; ++hh) { const f32x4 w = *(const LAS f32x4*)(wg + hh * D + 4 * lane + 256 * j); gd[hh] += (y.x * w.x + y.y * w.y) + (y.z * w.z + y.w * w.w); }
            asm volatile("" ::: "memory");
        }
    }
}
__device__ __forceinline__ float log_sigmoid(float x) { return fminf(x, 0.f) - log1pf(__expf(-fabsf(x))); }

#define MFMA16(a, b, c) __builtin_amdgcn_mfma_f32_16x16x32_bf16((a), (b), (c), 0, 0, 0)
__device__ __forceinline__ bf16x8 tr_frag(const LAS unsigned char* base, int pitch, int k0, int n0, int lane) {
    const int g = lane >> 4, q = (lane & 15) >> 2, p = lane & 3;
    const LAS unsigned char* a = base + ((k0 + 8 * g + q) * pitch + n0 + 4 * p) * 2;
    const s16x4 lo = __builtin_amdgcn_ds_read_tr16_b64_v4i16((LAS s16x4*)a);
    const s16x4 hi = __builtin_amdgcn_ds_read_tr16_b64_v4i16((LAS s16x4*)(a + 8 * pitch));
    bf16x8 r; r[0] = lo[0]; r[1] = lo[1]; r[2] = lo[2]; r[3] = lo[3]; r[4] = hi[0]; r[5] = hi[1]; r[6] = hi[2]; r[7] = hi[3]; return r;
}
constexpr int PV_PITCH = 136;
constexpr int VS_BYTES = 128 * PV_PITCH * 2;
__device__ __forceinline__ void stage_v(LAS unsigned char* dst, const bf16* proj, int row0, int col, int tid) {
#pragma unroll
    for (int it = 0; it < 4; ++it) { const int p = tid + 512 * it, j = p >> 4, ch = p & 15;
        const v4u x = *(const GAS v4u*)(proj + (size_t)(row0 + j) * NPROJ + col + 8 * ch);
        *(LAS v4u*)(dst + (j * PV_PITCH + 8 * ch) * 2) = x; }
}
__device__ __forceinline__ void stage_rot(LAS unsigned char* dst, const bf16* proj, const float* rot, int row0, int pos0, int col, float scale, float lgk, int tid) {
    const int j = tid >> 2, q = tid & 3;
    const bf16* p = proj + (size_t)(row0 + j) * NPROJ + col + 16 * q;
    const bf16x8 x1a = *(const GAS bf16x8*)p, x1b = *(const GAS bf16x8*)(p + 8), x2a = *(const GAS bf16x8*)(p + 64), x2b = *(const GAS bf16x8*)(p + 72);
    const GAS f32x4* rt = (const GAS f32x4*)(rot + ((size_t)(pos0 + j) * 64 + 16 * q) * 2);
    f32x4 cs[8];
#pragma unroll
    for (int i = 0; i < 8; ++i) cs[i] = rt[i];
    const float mul = scale * (lgk != 0.f ? __expf(lgk * (float)(127 - j)) : 1.0f);
    float y1[16], y2[16];
#pragma unroll
    for (int e = 0; e < 16; ++e) { const float a = bf2f(e < 8 ? x1a[e] : x1b[e - 8]), b = bf2f(e < 8 ? x2a[e] : x2b[e - 8]);
        const float c = cs[e >> 1][(e & 1) * 2], s = cs[e >> 1][(e & 1) * 2 + 1];
        y1[e] = (a * c - b * s) * mul; y2[e] = (a * s + b * c) * mul; }
    LAS unsigned char* o = dst + (j * PV_PITCH + 16 * q) * 2;
    v4u w;
    w.x = pk2(y1[0], y1[1]); w.y = pk2(y1[2], y1[3]); w.z = pk2(y1[4], y1[5]); w.w = pk2(y1[6], y1[7]); *(LAS v4u*)o = w;
    w.x = pk2(y1[8], y1[9]); w.y = pk2(y1[10], y1[11]); w.z = pk2(y1[12], y1[13]); w.w = pk2(y1[14], y1[15]); *(LAS v4u*)(o + 16) = w;
    w.x = pk2(y2[0], y2[1]); w.y = pk2(y2[2], y2[3]); w.z = pk2(y2[4], y2[5]); w.w = pk2(y2[6], y2[7]); *(LAS v4u*)(o + 128) = w;
    w.x = pk2(y2[8], y2[9]); w.y = pk2(y2[10], y2[11]); w.z = pk2(y2[12], y2[13]); w.w = pk2(y2[14], y2[15]); *(LAS v4u*)(o + 144) = w;
}
constexpr int MK_PITCH = 264;
__device__ __forceinline__ void stage_conv(LAS unsigned char* dst, const bf16* proj, const float* cw, const float* cb, int brow0, int t0, int col, int cch, float scale, const LAS float* rw, int tid) {
    const int dch = tid & 31, jg = tid >> 5, d0 = 8 * dch;
    float w[4][8], bias[8];
#pragma unroll
    for (int k = 0; k < 4; ++k) { const f32x4 a = *(const GAS f32x4*)(cw + k * 2048 + cch + d0), b = *(const GAS f32x4*)(cw + k * 2048 + cch + d0 + 4);
        w[k][0] = a.x; w[k][1] = a.y; w[k][2] = a.z; w[k][3] = a.w; w[k][4] = b.x; w[k][5] = b.y; w[k][6] = b.z; w[k][7] = b.w; }
    { const f32x4 a = *(const GAS f32x4*)(cb + cch + d0), b = *(const GAS f32x4*)(cb + cch + d0 + 4);
        bias[0] = a.x; bias[1] = a.y; bias[2] = a.z; bias[3] = a.w; bias[4] = b.x; bias[5] = b.y; bias[6] = b.z; bias[7] = b.w; }
    bf16x8 x[11];
#pragma unroll
    for (int r = 0; r < 11; ++r) { const int t = t0 + 8 * jg + r - 3;
        if (t >= 0) x[r] = *(const GAS bf16x8*)(proj + (size_t)(brow0 + t) * NPROJ + col + d0); else x[r] = (bf16x8){0, 0, 0, 0, 0, 0, 0, 0}; }
#pragma unroll
    for (int jj = 0; jj < 8; ++jj) {
        const float rs = scale * (rw ? rw[8 * jg + jj] : 1.0f);
        float y[8];
#pragma unroll
        for (int e = 0; e < 8; ++e) { float a = bias[e];
#pragma unroll
            for (int k = 0; k < 4; ++k) a += w[k][e] * bf2f(x[jj + k][e]);
            y[e] = a * __builtin_amdgcn_rcpf(1.0f + __expf(-a)) * rs; }
        v4u o; o.x = pk2(y[0], y[1]); o.y = pk2(y[2], y[3]); o.z = pk2(y[4], y[5]); o.w = pk2(y[6], y[7]);
        *(LAS v4u*)(dst + ((8 * jg + jj) * MK_PITCH + d0) * 2) = o; }
}
__device__ __forceinline__ void gate_scan(const float* GI, const float* LF, int row0, int h, float mprev, LAS float* sA, LAS float* sB, LAS float* sG, float& amax, float& blast, int lane) {
    const int r = row0 + 2 * lane;
    const float f0 = LF[(size_t)r * 4 + h], f1 = LF[(size_t)(r + 1) * 4 + h], i0 = GI[(size_t)r * 4 + h], i1 = GI[(size_t)(r + 1) * 4 + h];
    const float s = f0 + f1; float incl = s;
#pragma unroll
    for (int o = 1; o < 64; o <<= 1) { const float t = __shfl_up(incl, o); if (lane >= o) incl += t; }
    const float b0 = (incl - s) + f0, b1 = b0 + f1, a0 = i0 - b0, a1 = i1 - b1;
    float cm = fmaxf(a0, a1);
#pragma unroll
    for (int o = 1; o < 64; o <<= 1) { const float t = __shfl_up(cm, o); if (lane >= o) cm = fmaxf(cm, t); }
    float pe = __shfl_up(cm, 1); if (lane == 0) pe = -__builtin_inff();
    const float g0 = fmaxf(fmaxf(mprev, pe), a0), g1 = fmaxf(g0, a1);
    sA[2 * lane] = a0; sA[2 * lane + 1] = a1; sB[2 * lane] = b0; sB[2 * lane + 1] = b1; sG[2 * lane] = g0; sG[2 * lane + 1] = g1;
    amax = __shfl(cm, 63); blast = __shfl(b1, 63);
}
__device__ __forceinline__ float ret_log_gamma(int h) { return log1pf(-exp2f(-5.0f - (float)h)); }

template <bool ML>
__device__ __forceinline__ void phaseA_unit(Frame& F, int u) {
    constexpr int H = ML ? MH : RH, DK = ML ? MDK : RDK, DV = ML ? MDV : RDV, NSL = DV / 128, DT = DK / 128, VR = ML ? MVR : RDV, PK = ML ? MK_PITCH : PV_PITCH;
    constexpr int KB = 128 * PK * 2;
    const int b = u / (H * NCH), h = (u / NCH) % H, c = u % NCH, row0 = b * SEQ + c * CH, lane = F.lane, wave = F.wave, tid = F.tid;
    const bf16* proj = (const bf16*)(F.ws + WS_BIG);
    LAS unsigned char* kreg = F.lds; LAS unsigned char* vreg = F.lds + KB;
    LAS float* sA = (LAS float*)(F.lds + SM_OFF); LAS float* sB = sA + 128; LAS float* sG = sA + 256; LAS float* sW = sA + 384;
    bf16* st = (bf16*)(F.ws + (ML ? WS_ST_M : WS_ST_R)) + (size_t)u * VR * DK;
    if (ML) {
        if (wave == 0) { float amax, blast; gate_scan((const float*)(F.ws + WS_GI), (const float*)(F.ws + WS_LF), row0, h, -__builtin_inff(), sA, sB, sG, amax, blast, lane);
            sW[2 * lane] = __expf(sA[2 * lane] - amax); sW[2 * lane + 1] = __expf(sA[2 * lane + 1] - amax);
            if (lane == 0) { float* chs = (float*)(F.ws + WS_CHS) + 2 * u; chs[0] = amax; chs[1] = blast; } }
        __syncthreads();
        stage_conv(kreg, proj, F.in[7], F.in[8], b * SEQ, c * CH, C_MK + MDK * h, 1024 + MDK * h, 0.0625f, sW, tid);
    } else {
        stage_rot(kreg, proj, (const float*)(F.ws + WS_ROT), row0, c * CH, C_RK + RDK * h, 0.08838834764831845f, ret_log_gamma(h), tid);
    }
    const int g = lane >> 4, fr = lane & 15;
    const bf16x8 ones = (fr == 0) ? (bf16x8){0x3F80, 0x3F80, 0x3F80, 0x3F80, 0x3F80, 0x3F80, 0x3F80, 0x3F80} : (bf16x8){0, 0, 0, 0, 0, 0, 0, 0};
    for (int sl = 0; sl < NSL; ++sl) {
        stage_v(vreg, proj, row0, (ML ? C_MV + MDV * h : C_RV + RDV * h) + 128 * sl, tid);
        __syncthreads();
        f32x4 acc[DT][8], accn[DT];
#pragma unroll
        for (int dt = 0; dt < DT; ++dt) { accn[dt] = (f32x4){0.f, 0.f, 0.f, 0.f};
#pragma unroll
            for (int vt = 0; vt < 8; ++vt) acc[dt][vt] = (f32x4){0.f, 0.f, 0.f, 0.f}; }
#pragma unroll
        for (int ks = 0; ks < 4; ++ks) {
            bf16x8 af[DT];
#pragma unroll
            for (int dt = 0; dt < DT; ++dt) af[dt] = tr_frag(kreg, PK, 32 * ks, 16 * (wave * DT + dt), lane);
#pragma unroll
            for (int vt = 0; vt < 8; ++vt) { const bf16x8 bfv = tr_frag(vreg, PV_PITCH, 32 * ks, 16 * vt, lane);
#pragma unroll
                for (int dt = 0; dt < DT; ++dt) acc[dt][vt] = MFMA16(af[dt], bfv, acc[dt][vt]); }
            if (ML && sl == 0) {
#pragma unroll
                for (int dt = 0; dt < DT; ++dt) accn[dt] = MFMA16(af[dt], ones, accn[dt]); }
        }
#pragma unroll
        for (int dt = 0; dt < DT; ++dt) {
            const int d = 16 * (wave * DT + dt) + 4 * g;
#pragma unroll
            for (int vt = 0; vt < 8; ++vt) { const f32x4 a = acc[dt][vt]; v2u o; o.x = pk2(a[0], a[1]); o.y = pk2(a[2], a[3]);
                *(GAS v2u*)(st + (size_t)(128 * sl + 16 * vt + fr) * DK + d) = o; }
            if (ML && sl == 0 && fr == 0) { const f32x4 a = accn[dt]; v2u o; o.x = pk2(a[0], a[1]); o.y = pk2(a[2], a[3]); *(GAS v2u*)(st + (size_t)MDV * DK + d) = o; }
        }
        __syncthreads();
    }
}
__device__ __forceinline__ void phaseB(Frame& F) {
    const size_t gt = (size_t)F.vcu * 512 + F.tid, NT = (size_t)F.G * 512;
    for (size_t it = gt; it < (size_t)32 * RDV * 16; it += NT) {
        const int bh = (int)(it >> 12), rem = (int)(it & 4095), v = rem >> 4, dch = rem & 15, h = bh & 7;
        const float decay = __expf(ret_log_gamma(h) * 128.0f);
        bf16* p = (bf16*)(F.ws + WS_ST_R) + ((size_t)bh * NCH * RDV + v) * RDK + 8 * dch;
        float run[8];
#pragma unroll
        for (int e = 0; e < 8; ++e) run[e] = 0.f;
#pragma unroll 4
        for (int c = 0; c < NCH; ++c) { GAS v4u* q = (GAS v4u*)(p + (size_t)c * RDV * RDK); const v4u x = *q;
            v4u o; o.x = pk2(run[0], run[1]); o.y = pk2(run[2], run[3]); o.z = pk2(run[4], run[5]); o.w = pk2(run[6], run[7]); *q = o;
            run[0] = run[0] * decay + bflo(x.x); run[1] = run[1] * decay + bfhi(x.x); run[2] = run[2] * decay + bflo(x.y); run[3] = run[3] * decay + bfhi(x.y);
            run[4] = run[4] * decay + bflo(x.z); run[5] = run[5] * decay + bfhi(x.z); run[6] = run[6] * decay + bflo(x.w); run[7] = run[7] * decay + bfhi(x.w); }
    }
    for (size_t it = gt; it < (size_t)16 * 513 * 32; it += NT) {
        const int bh = (int)(it / (513 * 32)), rem = (int)(it % (513 * 32)), v = rem >> 5, dch = rem & 31;
        bf16* p = (bf16*)(F.ws + WS_ST_M) + ((size_t)bh * NCH * MVR + v) * MDK + 8 * dch;
        const float* chs = (const float*)(F.ws + WS_CHS) + (size_t)bh * NCH * 2; float* mp = (float*)(F.ws + WS_MP) + (size_t)bh * NCH;
        float run[8], m = 0.f;
#pragma unroll
        for (int e = 0; e < 8; ++e) run[e] = 0.f;
#pragma unroll 4
        for (int c = 0; c < NCH; ++c) { GAS v4u* q = (GAS v4u*)(p + (size_t)c * MVR * MDK); const v4u x = *q;
            const float am = chs[2 * c], bl = chs[2 * c + 1], gl = fmaxf(m, am), ws_ = __expf(m - gl), wd = __expf(am - gl);
            if (rem == 0) mp[c] = m;
            v4u o; o.x = pk2(run[0], run[1]); o.y = pk2(run[2], run[3]); o.z = pk2(run[4], run[5]); o.w = pk2(run[6], run[7]); *q = o;
            run[0] = run[0] * ws_ + wd * bflo(x.x); run[1] = run[1] * ws_ + wd * bfhi(x.x); run[2] = run[2] * ws_ + wd * bflo(x.y); run[3] = run[3] * ws_ + wd * bfhi(x.y);
            run[4] = run[4] * ws_ + wd * bflo(x.z); run[5] = run[5] * ws_ + wd * bfhi(x.z); run[6] = run[6] * ws_ + wd * bflo(x.w); run[7] = run[7] * ws_ + wd * bfhi(x.w);
            m = bl + gl; }
    }
}
template <bool ML>
__device__ __forceinline__ void phaseC_unit(Frame& F, int u) {
    constexpr int H = ML ? MH : RH, DK = ML ? MDK : RDK, DV = ML ? MDV : RDV, NSL = DV / 128, KS = DK / 32, VR = ML ? MVR : RDV, PK = ML ? MK_PITCH : PV_PITCH;
    constexpr int KB = 128 * PK * 2;
    const int b = u / (H * NCH), h = (u / NCH) % H, c = u % NCH, row0 = b * SEQ + c * CH, lane = F.lane, wave = F.wave, tid = F.tid;
    const bf16* proj = (const bf16*)(F.ws + WS_BIG);
    bf16* mixed = (bf16*)(F.ws + WS_XN);
    LAS unsigned char* kreg = F.lds; LAS unsigned char* qreg = F.lds + KB; LAS unsigned char* vreg = F.lds + KB; LAS unsigned char* preg = F.lds + KB + VS_BYTES + wave * (16 * PV_PITCH * 2);
    LAS float* sA = (LAS float*)(F.lds + SM_OFF); LAS float* sB = sA + 128; LAS float* sG = sA + 256;
    const bf16* st = (const bf16*)(F.ws + (ML ? WS_ST_M : WS_ST_R)) + (size_t)u * VR * DK;
    const int g = lane >> 4, fr = lane & 15, i = 16 * wave + fr;
    float mprev = 0.f;
    const float lg = ML ? 0.f : ret_log_gamma(h);
    if (ML) {
        mprev = ((const float*)(F.ws + WS_MP))[u];
        if (wave == 0) { float amax, blast; gate_scan((const float*)(F.ws + WS_GI), (const float*)(F.ws + WS_LF), row0, h, mprev, sA, sB, sG, amax, blast, lane); }
        stage_conv(kreg, proj, F.in[7], F.in[8], b * SEQ, c * CH, C_MK + MDK * h, 1024 + MDK * h, 0.0625f, nullptr, tid);
        stage_conv(qreg, proj, F.in[7], F.in[8], b * SEQ, c * CH, C_MQ + MDK * h, MDK * h, 1.0f, nullptr, tid);
    } else {
        stage_rot(kreg, proj, (const float*)(F.ws + WS_ROT), row0, c * CH, C_RK + RDK * h, 0.08838834764831845f, 0.f, tid);
        stage_rot(qreg, proj, (const float*)(F.ws + WS_ROT), row0, c * CH, C_RQ + RDK * h, 1.0f, 0.f, tid);
    }
    __syncthreads();
    bf16x8 qf[KS];
#pragma unroll
    for (int ks = 0; ks < KS; ++ks) qf[ks] = *(const LAS bf16x8*)(qreg + (i * PK + 32 * ks + 8 * g) * 2);
    float rowscale, gi = 0.f, en = 0.f;
    if (ML) { gi = sG[i]; rowscale = __expf(mprev - gi); en = __expf(-(sB[i] + gi)); }
    else rowscale = __expf(lg * (float)(i + 1));
    __syncthreads();
    float rowsum = 0.f;
#pragma unroll
    for (int jt = 0; jt < 8; ++jt) {
        f32x4 a = (f32x4){0.f, 0.f, 0.f, 0.f};
#pragma unroll
        for (int ks = 0; ks < KS; ++ks) { const bf16x8 kf = *(const LAS bf16x8*)(kreg + ((16 * jt + fr) * PK + 32 * ks + 8 * g) * 2); a = MFMA16(kf, qf[ks], a); }
        float p[4];
        f32x4 aj = (f32x4){0.f, 0.f, 0.f, 0.f}; if (ML) aj = *(const LAS f32x4*)(sA + 16 * jt + 4 * g);
#pragma unroll
        for (int r = 0; r < 4; ++r) { const int j = 16 * jt + 4 * g + r;
            const float w = ML ? __expf(aj[r] - gi) : __expf(lg * (float)(i - j));
            p[r] = (j <= i) ? a[r] * w : 0.f; rowsum += p[r]; }
        v2u o; o.x = pk2(p[0], p[1]); o.y = pk2(p[2], p[3]);
        *(LAS v2u*)(preg + (fr * PV_PITCH + 16 * jt + 4 * g) * 2) = o;
    }
    float inv = 1.0f;
    if (ML) {
        rowsum += __shfl_xor(rowsum, 16); rowsum += __shfl_xor(rowsum, 32);
        float qn = 0.f; const bf16* nrow = st + (size_t)MDV * DK;
#pragma unroll
        for (int ks = 0; ks < KS; ++ks) { const bf16x8 nv = *(const GAS bf16x8*)(nrow + 32 * ks + 8 * g);
#pragma unroll
            for (int e = 0; e < 8; ++e) qn += bf2f(qf[ks][e]) * bf2f(nv[e]); }
        qn += __shfl_xor(qn, 16); qn += __shfl_xor(qn, 32);
        const float nq = rowsum + rowscale * qn;
        inv = 1.0f / fmaxf(fabsf(nq), en);
    }
    const int ocol = ML ? 2048 + MDV * h : RDV * h, gcol = ML ? C_MO + MDV * h : C_RG + RDV * h;
    bf16* orow = mixed + (size_t)(row0 + i) * D + ocol;
    float sumsq = 0.f;
    for (int sl = 0; sl < NSL; ++sl) {
        stage_v(vreg, proj, row0, (ML ? C_MV + MDV * h : C_RV + RDV * h) + 128 * sl, tid);
        __syncthreads();
        f32x4 acc[8];
#pragma unroll
        for (int vt = 0; vt < 8; ++vt) { f32x4 a = (f32x4){0.f, 0.f, 0.f, 0.f};
#pragma unroll
            for (int ks = 0; ks < KS; ++ks) { const bf16x8 sf = *(const GAS bf16x8*)(st + (size_t)(128 * sl + 16 * vt + fr) * DK + 32 * ks + 8 * g); a = MFMA16(sf, qf[ks], a); }
            acc[vt] = a * rowscale; }
#pragma unroll
        for (int k2 = 0; k2 < 4; ++k2) { const bf16x8 pf = *(const LAS bf16x8*)(preg + (fr * PV_PITCH + 32 * k2 + 8 * g) * 2);
#pragma unroll
            for (int vt = 0; vt < 8; ++vt) { const bf16x8 vf = tr_frag(vreg, PV_PITCH, 32 * k2, 16 * vt, lane); acc[vt] = MFMA16(vf, pf, acc[vt]); } }
#pragma unroll
        for (int vt = 0; vt < 8; ++vt) { const f32x4 a = acc[vt] * inv; sumsq += (a[0] * a[0] + a[1] * a[1]) + (a[2] * a[2] + a[3] * a[3]);
            v2u o; o.x = pk2(a[0], a[1]); o.y = pk2(a[2], a[3]); *(GAS v2u*)(orow + 128 * sl + 16 * vt + 4 * g) = o; }
        __syncthreads();
    }
    sumsq += __shfl_xor(sumsq, 16); sumsq += __shfl_xor(sumsq, 32);
    const float rstd = 1.0f / sqrtf(sumsq * (1.0f / DV) + NORM_EPS);
    VM_WAIT();
    const float* hn = F.in[ML ? 12 : 11] + (ML ? MDV : RDV) * h;
    const bf16* grow = proj + (size_t)(row0 + i) * NPROJ + gcol;
#pragma unroll 4
    for (int t = 0; t < NSL * 8; ++t) { const int vo = 16 * t + 4 * g;
        const v2u x = *(const GAS v2u*)(orow + vo), gt = *(const GAS v2u*)(grow + vo); const f32x4 gn = *(const GAS f32x4*)(hn + vo);
        float y[4] = {bflo(x.x), bfhi(x.x), bflo(x.y), bfhi(x.y)}; const float gv[4] = {bflo(gt.x), bfhi(gt.x), bflo(gt.y), bfhi(gt.y)};
#pragma unroll
        for (int e = 0; e < 4; ++e) { const float sg = __builtin_amdgcn_rcpf(1.0f + __expf(-gv[e])); y[e] = y[e] * rstd * gn[e] * (ML ? sg : gv[e] * sg); }
        v2u o; o.x = pk2(y[0], y[1]); o.y = pk2(y[2], y[3]); *(GAS v2u*)(orow + vo) = o; }
}
struct Args { const float* in[19]; float* out; unsigned char* ws; };
__global__ void __launch_bounds__(NWAVES * 64, 2) hybrid_fwd(Args args) {
    extern __shared__ __attribute__((aligned(16))) unsigned char lds[];
    Frame F;
    F.lds = (LAS unsigned char*)lds;
    F.MISC = (volatile LAS unsigned*)(F.lds + MISC_OFF);
    F.tid = threadIdx.x; F.lane = F.tid & 63; F.wave = __builtin_amdgcn_readfirstlane(F.tid >> 6);
    F.G = gridDim.x; { const int bx = blockIdx.x; F.vcu = (F.G % 8 == 0) ? (bx % 8) * (F.G / 8) + bx / 8 : bx; }
#pragma unroll
    for (int i = 0; i < 19; ++i) F.in[i] = args.in[i];
    F.out = args.out; F.ws = args.ws;
    unsigned char* ws = args.ws;
    F.ctl = (gu32*)(ws + WS_CTL);
    for (int u = F.tid; u < (LDS_BYTES - LDSCTL_OFF) / 4; u += NWAVES * 64) ((LAS unsigned*)(F.lds + LDSCTL_OFF))[u] = 0u;
    __syncthreads();
    XcdBarrier bar = xcd_barrier_post((unsigned*)(F.ctl + CW_BAR), F.MISC + 8);
#define GRID_BAR() xcd_barrier(bar)
    const int gw = F.vcu * NWAVES + F.wave, NGW = F.G * NWAVES;
    bf16* XN = (bf16*)(ws + WS_XN); bf16* BIG = (bf16*)(ws + WS_BIG);
    float dummy[8];

#ifndef PHASE_MASK
#define PHASE_MASK 0xFFFF
#endif
#define PH(n) if constexpr ((PHASE_MASK >> (n)) & 1)
    PH(0) {
        LAS float* scr = (LAS float*)(F.lds + RING_OFF + F.wave * 16384);
        constexpr int I_GU = (D / 64) * (FF / 32), I_DN = (FF / 64) * (D / 32), I_IN = (D / 64) * (NPROJ / 32), I_OUT = (D / 64) * (D / 32);
        constexpr int NITEMS = 4 * I_GU + 2 * I_DN + I_IN + I_OUT;
        for (int it = gw; it < NITEMS; it += NGW) {
            int r = it;
            if (r < I_GU) { transpose_gu(F.in[2], 0, (bf16*)(ws + WS_WGU1), scr, r, F.lane); continue; } r -= I_GU;
            if (r < I_GU) { transpose_gu(F.in[3], 1, (bf16*)(ws + WS_WGU1), scr, r, F.lane); continue; } r -= I_GU;
            if (r < I_DN) { transpose_plain(F.in[4], FF, D, D, (bf16*)(ws + WS_WD1), scr, r, F.lane); continue; } r -= I_DN;
            if (r < I_IN) { transpose_plain(F.in[6], D, NPROJ, NPROJ_ALL, (bf16*)(ws + WS_WIN), scr, r, F.lane); continue; } r -= I_IN;
            if (r < I_OUT) { transpose_plain(F.in[13], D, D, D, (bf16*)(ws + WS_WOUT), scr, r, F.lane); continue; } r -= I_OUT;
            if (r < I_GU) { transpose_gu(F.in[15], 0, (bf16*)(ws + WS_WGU2), scr, r, F.lane); continue; } r -= I_GU;
            if (r < I_GU) { transpose_gu(F.in[16], 1, (bf16*)(ws + WS_WGU2), scr, r, F.lane); continue; } r -= I_GU;
            transpose_plain(F.in[17], FF, D, D, (bf16*)(ws + WS_WD2), scr, r, F.lane);
        }
        const size_t gt = (size_t)F.vcu * 512 + F.tid, NT = (size_t)F.G * 512;
        for (size_t e = gt; e < (size_t)SEQ * 64; e += NT) {
            const int pos = (int)(e >> 6), j = (int)(e & 63);
            double rev = (double)pos * INV_FREQ[j] * 0.15915494309189535; rev -= __builtin_floor(rev);
            const float rf = (float)rev;
            f32x2 cs; cs.x = __builtin_amdgcn_cosf(rf); cs.y = __builtin_amdgcn_sinf(rf);
            ((GAS f32x2*)(ws + WS_ROT))[e] = cs;
        }
        for (size_t e = gt; e < (size_t)8 * D; e += NT) { const int hh = (int)(e >> 12), k = (int)(e & 4095); ((float*)(ws + WS_WG8))[e] = F.in[6][(size_t)k * NPROJ_ALL + NPROJ + hh]; }
        for (int m = gw; m < M; m += NGW) norm_row<0>(F.in[0] + (size_t)m * D, F.in[1], XN + (size_t)m * D, nullptr, nullptr, dummy, F.lane);
    }
    GRID_BAR();
    PH(1) { pg8::Gemm g{XN, (const bf16*)(ws + WS_WGU1), M, 2 * FF, D}; pg8::StaticOrder S; S.init(M, 2 * FF, F.G, (int)blockIdx.x);
      pg8::EpiSwiGLU E{BIG, FF};
      pg8::gemm_phase<pg8::EpiSwiGLU, pg8::StaticOrder, PG8_ALIGN, PG8_SP2>(F.lds + RING_OFF, g, S, E); }
    GRID_BAR();
    PH(2) { pg8::Gemm g{BIG, (const bf16*)(ws + WS_WD1), M, D, FF}; pg8::StaticOrder S; S.init(M, D, F.G, (int)blockIdx.x);
      pg8::EpiResF32 E{F.in[0], F.out, D, 0.5f};
      pg8::gemm_phase<pg8::EpiResF32, pg8::StaticOrder, PG8_ALIGN, PG8_SP2>(F.lds + RING_OFF, g, S, E); }
    GRID_BAR();
    PH(3) {
        LAS float* wg = (LAS float*)(F.lds + RING_OFF);
        for (int e = F.tid; e < 8 * D / 4; e += NWAVES * 64) ((LAS f32x4*)wg)[e] = ((const GAS f32x4*)(ws + WS_WG8))[e];
        __syncthreads();
        float* GI = (float*)(ws + WS_GI); float* LFp = (float*)(ws + WS_LF);
        for (int m = gw; m < M; m += NGW) {
            float gd[8];
            norm_row<1>(F.out + (size_t)m * D, F.in[5], XN + (size_t)m * D, nullptr, wg, gd, F.lane);
#pragma unroll
            for (int hh = 0; hh < 8; ++hh) gd[hh] = wave_sum(gd[hh]);
            if (F.lane == 0) {
#pragma unroll
                for (int hh = 0; hh < 4; ++hh) { GI[(size_t)m * 4 + hh] = gd[hh] + F.in[9][hh]; LFp[(size_t)m * 4 + hh] = log_sigmoid(gd[4 + hh] + F.in[10][hh]); }
            }
        }
        __syncthreads();
    }
    GRID_BAR();
    PH(4) { pg8::Gemm g{XN, (const bf16*)(ws + WS_WIN), M, NPROJ, D}; pg8::StaticOrder S; S.init(M, NPROJ, F.G, (int)blockIdx.x);
      pg8::EpiBf16 E{BIG, NPROJ};
      pg8::gemm_phase<pg8::EpiBf16, pg8::StaticOrder, PG8_ALIGN, PG8_SP2>(F.lds + RING_OFF, g, S, E); }
    GRID_BAR();
    PH(5) { for (int u = F.vcu; u < BATCH * RH * NCH; u += F.G) phaseA_unit<false>(F, u); }
    PH(13) { for (int u = F.vcu; u < BATCH * MH * NCH; u += F.G) phaseA_unit<true>(F, u); }
    GRID_BAR();
    PH(6) { phaseB(F); }
    GRID_BAR();
    PH(7) { for (int u = F.vcu; u < BATCH * RH * NCH; u += F.G) phaseC_unit<false>(F, u); }
    PH(14) { for (int u = F.vcu; u < BATCH * MH * NCH; u += F.G) phaseC_unit<true>(F, u); }
    GRID_BAR();
    PH(8) { pg8::Gemm g{XN, (const bf16*)(ws + WS_WOUT), M, D, D}; pg8::StaticOrder S; S.init(M, D, F.G, (int)blockIdx.x);
      pg8::EpiResF32 E{F.out, F.out, D, 1.0f};
      pg8::gemm_phase<pg8::EpiResF32, pg8::StaticOrder, PG8_ALIGN, PG8_SP2>(F.lds + RING_OFF, g, S, E); }
    GRID_BAR();
    PH(9) for (int m = gw; m < M; m += NGW) norm_row<0>(F.out + (size_t)m * D, F.in[14], XN + (size_t)m * D, nullptr, nullptr, dummy, F.lane);
    GRID_BAR();
    PH(10) { pg8::Gemm g{XN, (const bf16*)(ws + WS_WGU2), M, 2 * FF, D}; pg8::StaticOrder S; S.init(M, 2 * FF, F.G, (int)blockIdx.x);
      pg8::EpiSwiGLU E{BIG, FF};
      pg8::gemm_phase<pg8::EpiSwiGLU, pg8::StaticOrder, PG8_ALIGN, PG8_SP2>(F.lds + RING_OFF, g, S, E); }
    GRID_BAR();
    PH(11) { pg8::Gemm g{BIG, (const bf16*)(ws + WS_WD2), M, D, FF}; pg8::StaticOrder S; S.init(M, D, F.G, (int)blockIdx.x);
      pg8::EpiResF32 E{F.out, F.out, D, 0.5f};
      pg8::gemm_phase<pg8::EpiResF32, pg8::StaticOrder, PG8_ALIGN, PG8_SP2>(F.lds + RING_OFF, g, S, E); }
    GRID_BAR();
    PH(12) for (int m = gw; m < M; m += NGW) norm_row<2>(F.out + (size_t)m * D, F.in[18], nullptr, F.out + (size_t)m * D, nullptr, dummy, F.lane);
}

extern "C" void kernel_launch(void* const* d_in, const int* in_sizes, int n_in, void* d_out, int out_size, void* d_ws, size_t ws_size, hipStream_t stream) {
    static int grid = 0;
    if (grid == 0) {
        if (n_in != 19 || in_sizes[0] != M * D || out_size != M * D || ws_size < WS_END) { fprintf(stderr, "kernel_launch: unexpected problem: n_in %d in0 %d out %d ws %zu (need %zu); nothing launched\n", n_in, n_in > 0 ? in_sizes[0] : -1, out_size, ws_size, (size_t)WS_END); grid = -1; return; }
        int dev = 0, cus = 0, per_cu = 0;
        if (hipGetDevice(&dev) != hipSuccess || hipDeviceGetAttribute(&cus, hipDeviceAttributeMultiprocessorCount, dev) != hipSuccess) { fprintf(stderr, "kernel_launch: device query failed\n"); grid = -1; return; }
        if (hipFuncSetAttribute((const void*)hybrid_fwd, hipFuncAttributeMaxDynamicSharedMemorySize, LDS_BYTES) != hipSuccess) { fprintf(stderr, "kernel_launch: hipFuncSetAttribute failed\n"); grid = -1; return; }
        if (hipOccupancyMaxActiveBlocksPerMultiprocessor(&per_cu, (const void*)hybrid_fwd, NWAVES * 64, LDS_BYTES) != hipSuccess || per_cu < 1) fprintf(stderr, "kernel_launch: occupancy query reports %d workgroups per CU\n", per_cu);
        (void)hipGetLastError();
        grid = cus;
    }
    if (grid < 0) return;
    if (hipMemsetAsync((char*)d_ws + WS_CTL, 0, CTL_ZERO_BYTES, stream) != hipSuccess) { fprintf(stderr, "kernel_launch: memset failed\n"); return; }
    Args a{};
    for (int i = 0; i < 19; ++i) a.in[i] = (const float*)d_in[i];
    a.out = (float*)d_out; a.ws = (unsigned char*)d_ws;
    hipLaunchKernelGGL(hybrid_fwd, dim3(grid), dim3(NWAVES * 64), LDS_BYTES, stream, a);
    const hipError_t le = hipPeekAtLastError();
    if (le != hipSuccess) fprintf(stderr, "kernel_launch: launch failed: %s\n", hipGetErrorName(le));
}
```

```cpp
#include <hip/hip_runtime.h>
#include <cstdio>
#include <cstdint>
namespace pg8 {
#define PG8_LAS __attribute__((address_space(3)))
typedef unsigned short bf16_t;
typedef short bf16x8 __attribute__((ext_vector_type(8)));
typedef float f32x4 __attribute__((ext_vector_type(4)));
typedef unsigned u32x4 __attribute__((ext_vector_type(4)));
typedef int i32x4 __attribute__((ext_vector_type(4)));
typedef int i32x8 __attribute__((ext_vector_type(8)));
typedef unsigned u32x2 __attribute__((ext_vector_type(2)));
constexpr int BM = 256, BK = 64, HALF = 128, HTB = HALF * BK * 2  , STAGE_BYTES = 8 * HTB, NXCD = 8, WGM = 8;

__host__ __device__ __forceinline__ int lds_byte(int r, int c) { const int st = (r >> 4) * 2 + (c >> 5), rr = r & 15, cc = c & 31, ob = rr * 64 + cc * 2; return st * 1024 + (ob ^ (((ob >> 9) & 1) << 5)); }
__host__ __device__ __forceinline__ void stage_rc(int b, int& R, int& C) { const int st = b / 1024, sb = b % 1024, swz = sb ^ (((sb >> 9) & 1) << 5); R = (st >> 1) * 16 + swz / 64; C = (st & 1) * 32 + (swz % 64) / 2; }
__host__ __device__ __forceinline__ int perm32(int rho) { const int n = rho >> 4, i = rho & 15; return 8 * (i >> 2) + 4 * n + (i & 3); }

struct Unit { int pm, pn; };
struct Gemm { const bf16_t* A; const bf16_t* Bt; int M, N, K; };

struct StaticOrder {
    int nM, nN, nwg, G, c;
    __host__ __device__ void init(int M, int N, int G_, int c_) { nM = M / BM; nN = N / BM; nwg = nM * nN; G = G_; c = c_; }
    __host__ __device__ bool next(int i, Unit& u) const {
        const long L = (long)i * G + c; if (L >= nwg) return false;
        int wgid = (int)L; { const int q = nwg / NXCD, r = nwg % NXCD, xcd = wgid % NXCD, off = wgid / NXCD; wgid = (xcd < r ? xcd * (q + 1) : r * (q + 1) + (xcd - r) * q) + off; }
        const int nig = WGM * nN, gid = wgid / nig, fm = gid * WGM, gsz = (nM - fm) < WGM ? (nM - fm) : WGM;
        u.pm = fm + ((wgid % nig) % gsz); u.pn = (wgid % nig) / gsz; return true;
    }
    __device__ __forceinline__ void a_ready(const Unit&) const {}
    __device__ __forceinline__ void done(const Unit&) const {}
};


template <int PMX, int NM, int NN> struct SweepOrder {
    int c;
    __host__ __device__ void init(int, int, int, int c_) { c = c_; }
    __host__ __device__ bool next(int i, Unit& u) const {
        constexpr int PNR = 32 / PMX;
        constexpr int nblk = NN / PNR; const int sweep = i / nblk, pnb = i % nblk, x = c & 7, j = c >> 3;
        if (sweep * 8 * PMX >= NM) return false;
        u.pm = sweep * 8 * PMX + x * PMX + (j % PMX); u.pn = pnb * PNR + j / PMX; return true;
    }
    __device__ __forceinline__ void a_ready(const Unit&) const {}
    __device__ __forceinline__ void done(const Unit&) const {}
};

template <int NM, int SPM = 4> struct Sweep2DOrder {
    static constexpr bool SPLITK = false;
    int c;
    __host__ __device__ void init(int, int, int, int c_) { c = c_; }
    __host__ __device__ bool next(int i, Unit& u) const {
        constexpr int PNR = 32 / SPM, XB = 16 / PNR;
        if (i * 16 >= NM) return false;
        const int x = c & 7, j = c >> 3;
        u.pm = i * 16 + (x / XB) * SPM + (j % SPM); u.pn = (x % XB) * PNR + (j / SPM); return true;
    }
    __device__ __forceinline__ void a_ready(const Unit&) const {}
    __device__ __forceinline__ void done(const Unit&) const {}
};

__device__ __forceinline__ unsigned cvt_pk_bf16(float lo, float hi) { unsigned r; asm volatile("v_cvt_pk_bf16_f32 %0, %1, %2" : "=v"(r) : "v"(lo), "v"(hi)); return r; }

__host__ __device__ __forceinline__ void proj_seg(int col, int& seg_start, int& hw, int& H) {
    if (col < 2048) { hw = 128; H = 8; seg_start = col & ~1023; }
    else if (col < 6144) { hw = 256; H = 8; seg_start = 2048 + ((col - 2048) & ~2047); }
    else if (col < 8192) { hw = 256; H = 4; seg_start = 6144 + ((col - 6144) & ~1023); }
    else { hw = 512; H = 4; seg_start = 8192 + ((col - 8192) & ~2047); }
}
struct EpiProj {
    static constexpr bool PERM = true, AFTER_DRAIN = false;
    bf16_t* O; int Mrows, SEQL;
    __device__ __forceinline__ void operator()(const f32x4 (&acc)[2][2][4][2], const Unit& u, int wr, int wc, int fr, int fq) const {
        const int row0 = u.pm * BM + wr * 64 + fr;
        size_t cbase[2]; int hwv[2];
#pragma unroll
        for (int bj = 0; bj < 2; ++bj) { const int cb = u.pn * BM + bj * HALF; int ss, hw, H; proj_seg(cb, ss, hw, H);
            const int cs = cb - ss, h = cs / hw, d0 = cs % hw;
            hwv[bj] = hw; cbase[bj] = (size_t)ss * Mrows + (size_t)h * SEQL * hw + d0 + wc * 32 + 8 * fq + (size_t)0;
            cbase[bj] += 0; (void)H; hwv[bj] = hw | (H << 16); }
#pragma unroll
        for (int ai = 0; ai < 2; ++ai)
#pragma unroll
            for (int m = 0; m < 4; ++m) { const int row = row0 + ai * HALF + m * 16, b = row / SEQL, s = row % SEQL;
#pragma unroll
                for (int bj = 0; bj < 2; ++bj) { const int hw = hwv[bj] & 0xffff, H = hwv[bj] >> 16; const f32x4 v0 = acc[ai][bj][m][0], v1 = acc[ai][bj][m][1];
                    u32x4 w; w.x = cvt_pk_bf16(v0[0], v0[1]); w.y = cvt_pk_bf16(v0[2], v0[3]); w.z = cvt_pk_bf16(v1[0], v1[1]); w.w = cvt_pk_bf16(v1[2], v1[3]);
                    __builtin_nontemporal_store(w, (u32x4*)(O + cbase[bj] + ((size_t)b * H * SEQL + s) * hw)); } }
    }
};
__device__ __forceinline__ float silu_mul(float g, float u) { return g * u * __builtin_amdgcn_rcpf(1.0f + __builtin_amdgcn_exp2f(-1.44269504089f * g)); }
struct EpiSwiGLU {
    static constexpr bool PERM = true, AFTER_DRAIN = false;
    bf16_t* O; int ldc;
    __device__ __forceinline__ void operator()(const f32x4 (&acc)[2][2][4][2], const Unit& u, int wr, int wc, int fr, int fq) const {
        const int row0 = u.pm * BM + wr * 64 + fr, col0 = u.pn * HALF + wc * 32 + 8 * fq;
#pragma unroll
        for (int ai = 0; ai < 2; ++ai)
#pragma unroll
            for (int m = 0; m < 4; ++m) { const int row = row0 + ai * HALF + m * 16; bf16_t* rowp = O + ((size_t)((row >> 8) * (ldc >> 6) + (col0 >> 6)) * 256 + (row & 255)) * 64 + (col0 & 63);
                const f32x4 g0 = acc[ai][0][m][0], g1 = acc[ai][0][m][1], u0 = acc[ai][1][m][0], u1 = acc[ai][1][m][1];
                u32x4 w; w.x = cvt_pk_bf16(silu_mul(g0[0], u0[0]), silu_mul(g0[1], u0[1])); w.y = cvt_pk_bf16(silu_mul(g0[2], u0[2]), silu_mul(g0[3], u0[3]));
                w.z = cvt_pk_bf16(silu_mul(g1[0], u1[0]), silu_mul(g1[1], u1[1])); w.w = cvt_pk_bf16(silu_mul(g1[2], u1[2]), silu_mul(g1[3], u1[3]));
                __builtin_nontemporal_store(w, (u32x4*)rowp); }
    }
};
template <bool BASE_F32> struct EpiResBf16 {
    static constexpr bool PERM = true, AFTER_DRAIN = false;
    const void* base; bf16_t* O; int ldc; float alpha;
    __device__ __forceinline__ void operator()(const f32x4 (&acc)[2][2][4][2], const Unit& u, int wr, int wc, int fr, int fq) const {
        const int row0 = u.pm * BM + wr * 64 + fr, col0 = u.pn * BM + wc * 32 + 8 * fq;
#pragma unroll
        for (int ai = 0; ai < 2; ++ai)
#pragma unroll
            for (int m = 0; m < 4; ++m) { const size_t off = (size_t)(row0 + ai * HALF + m * 16) * ldc + col0;
#pragma unroll
                for (int bj = 0; bj < 2; ++bj) { const size_t o = off + bj * HALF; f32x4 b0, b1;
                    if (BASE_F32) { b0 = *(const f32x4*)((const float*)base + o); b1 = *(const f32x4*)((const float*)base + o + 4); }
                    else { const u32x4 bw = *(const u32x4*)((const bf16_t*)base + o);
                        b0 = (f32x4){__builtin_bit_cast(float, bw.x << 16), __builtin_bit_cast(float, bw.x & 0xffff0000u), __builtin_bit_cast(float, bw.y << 16), __builtin_bit_cast(float, bw.y & 0xffff0000u)};
                        b1 = (f32x4){__builtin_bit_cast(float, bw.z << 16), __builtin_bit_cast(float, bw.z & 0xffff0000u), __builtin_bit_cast(float, bw.w << 16), __builtin_bit_cast(float, bw.w & 0xffff0000u)}; }
                    const f32x4 r0 = b0 + alpha * acc[ai][bj][m][0], r1 = b1 + alpha * acc[ai][bj][m][1];
                    u32x4 w; w.x = cvt_pk_bf16(r0[0], r0[1]); w.y = cvt_pk_bf16(r0[2], r0[3]); w.z = cvt_pk_bf16(r1[0], r1[1]); w.w = cvt_pk_bf16(r1[2], r1[3]);
                    *(u32x4*)(O + o) = w; }
                if (m & 1) asm volatile("" ::: "memory"); }
    }
};
template <bool P> struct EpiNull {
    static constexpr bool PERM = P, AFTER_DRAIN = false;
    __device__ __forceinline__ void operator()(const f32x4 (&acc)[2][2][4][2], const Unit& u, int wr, int wc, int fr, int fq) const {
#pragma unroll
        for (int ai = 0; ai < 2; ++ai)
#pragma unroll
            for (int bj = 0; bj < 2; ++bj)
#pragma unroll
                for (int m = 0; m < 4; ++m)
#pragma unroll
                    for (int n = 0; n < 2; ++n) asm volatile("" :: "v"(acc[ai][bj][m][n]));
    }
};
__host__ __device__ __forceinline__ size_t blk8_off(int r, int k, int nkt8) { return ((size_t)((r >> 8) * nkt8 + (k >> 7)) * 256 + (r & 255)) * 128 + (k & 127); }
__device__ __forceinline__ float sat_e4m3(float v) { return __builtin_amdgcn_fmed3f(v, -448.0f, 448.0f); }
__device__ __forceinline__ unsigned pack4_fp8(float a, float b, float c, float d) { int w = __builtin_amdgcn_cvt_pk_fp8_f32(sat_e4m3(a), sat_e4m3(b), 0, false); w = __builtin_amdgcn_cvt_pk_fp8_f32(sat_e4m3(c), sat_e4m3(d), w, true); return (unsigned)w; }
constexpr float F8_HID_SCALE = 16.0f, F8_W_SCALE = 2048.0f, F8_X_SCALE = 16.0f;
template <bool SCALED> struct EpiSwiGLU8T {
    static constexpr bool PERM = true, AFTER_DRAIN = false;
    unsigned char* O; int ldc; int pn0; float pre;
    __device__ __forceinline__ float hm(float g, float u) const { return SCALED ? F8_HID_SCALE * silu_mul(pre * g, pre * u) : F8_HID_SCALE * silu_mul(g, u); }
    __device__ __forceinline__ void operator()(const f32x4 (&acc)[2][2][4][2], const Unit& u, int wr, int wc, int fr, int fq) const {
        const int row0 = u.pm * BM + wr * 64 + fr, col0 = (u.pn + pn0) * HALF + wc * 32 + 8 * fq;
#pragma unroll
        for (int ai = 0; ai < 2; ++ai)
#pragma unroll
            for (int m = 0; m < 4; ++m) { const int row = row0 + ai * HALF + m * 16;
                const f32x4 g0 = acc[ai][0][m][0], g1 = acc[ai][0][m][1], u0 = acc[ai][1][m][0], u1 = acc[ai][1][m][1];
                u32x2 w;
                w.x = pack4_fp8(hm(g0[0], u0[0]), hm(g0[1], u0[1]), hm(g0[2], u0[2]), hm(g0[3], u0[3]));
                w.y = pack4_fp8(hm(g1[0], u1[0]), hm(g1[1], u1[1]), hm(g1[2], u1[2]), hm(g1[3], u1[3]));
                __builtin_nontemporal_store(w, (u32x2*)(O + blk8_off(row, col0, ldc >> 7))); }
    }
};
struct EpiResF32 {
    static constexpr bool PERM = false, AFTER_DRAIN = false;
    const float* base; float* out; int ldc; float alpha;
    __device__ __forceinline__ void operator()(const f32x4 (&acc)[2][2][4][2], const Unit& u, int wr, int wc, int fr, int fq) const {
        const int row0 = u.pm * BM + wr * 64 + fr, col0 = u.pn * BM + wc * 32 + 4 * fq;
#pragma unroll
        for (int ai = 0; ai < 2; ++ai)
#pragma unroll
            for (int m = 0; m < 4; ++m) { const size_t off = (size_t)(row0 + ai * HALF + m * 16) * ldc + col0;
#pragma unroll
                for (int bj = 0; bj < 2; ++bj)
#pragma unroll
                    for (int n = 0; n < 2; ++n) { const f32x4 bs = *(const f32x4*)(base + off + bj * HALF + n * 16); *(f32x4*)(out + off + bj * HALF + n * 16) = bs + alpha * acc[ai][bj][m][n]; }
                asm volatile("" ::: "memory"); }
    }
};

template <class Epi, class Sched, bool ALIGN_EPI = false, bool SP2 = false, bool F8 = false>
__device__ __forceinline__ void gemm_phase(PG8_LAS unsigned char* lds, const Gemm g, const Sched& S, const Epi& E) {
    int tid_ = threadIdx.x; asm volatile("" : "+v"(tid_));
    const int tid = tid_, wid = __builtin_amdgcn_readfirstlane(tid >> 6), lane = tid & 63, wr = wid >> 2, wc = wid & 3, fr = lane & 15, fq = lane >> 4;
    const int K = g.K, nt = K / BK;
    unsigned voffA[2], voffB[2];
#pragma unroll
    for (int i = 0; i < 2; ++i) { int R, C; stage_rc(tid * 16 + i * 8192, R, C); const int Rb = Epi::PERM ? ((R & ~31) + perm32(R & 31)) : R;
        voffA[i] = (unsigned)(R * BK + C) * 2u; voffB[i] = (unsigned)(Rb * BK + C) * 2u; }
    const size_t kstep = (size_t)(BM * BK * 2);
    const size_t hstep = (size_t)HALF * BK * 2;
    const size_t tstep = (size_t)nt * kstep;
    const unsigned ldsw = (unsigned)wid * 1024u;
    const int fcol = F8 ? 32 * (fq >> 1) + 16 * (fq & 1) : fq * 8;
    const int aoff = lds_byte(wr * 64 + fr, fcol), boff = lds_byte(wc * 32 + fr, fcol);
#define PG8_SA(b, h) (((b) * 2 + (h)) * HTB)
#define PG8_SB(b, h) ((4 + (b) * 2 + (h)) * HTB)
#define PG8_STAGE(bufoff, gbase, voff) do { _Pragma("unroll") for (int _i = 0; _i < 2; ++_i) \
        __builtin_amdgcn_global_load_lds((const unsigned*)((const char*)(gbase) + (voff)[_i]), (PG8_LAS unsigned*)(lds + (bufoff) + ldsw + _i * 8192), 16, 0, 0); } while (0)
#define PG8_LD32(p_) __builtin_shufflevector(*(const PG8_LAS i32x4*)(p_), *(const PG8_LAS i32x4*)((p_) + 16), 0, 1, 2, 3, 4, 5, 6, 7)
#define PG8_LDA(dst, b, h) do { if constexpr (F8) { _Pragma("unroll") for (int m = 0; m < 4; ++m) dst##8[m] = PG8_LD32(lds + PG8_SA(b, h) + aoff + m * 2048); } \
        else { _Pragma("unroll") for (int m = 0; m < 4; ++m) _Pragma("unroll") for (int k = 0; k < 2; ++k) dst[m][k] = *(const PG8_LAS bf16x8*)(lds + PG8_SA(b, h) + aoff + m * 2048 + k * 1024); } } while (0)
#define PG8_LDB(dst, b, h) do { if constexpr (F8) { _Pragma("unroll") for (int n = 0; n < 2; ++n) dst##8[n] = PG8_LD32(lds + PG8_SB(b, h) + boff + n * 2048); } \
        else { _Pragma("unroll") for (int n = 0; n < 2; ++n) _Pragma("unroll") for (int k = 0; k < 2; ++k) dst[n][k] = *(const PG8_LAS bf16x8*)(lds + PG8_SB(b, h) + boff + n * 2048 + k * 1024); } } while (0)
#define PG8_MMA(ai, bj, At, Bt) do { __builtin_amdgcn_s_setprio(1); \
        if constexpr (F8) { _Pragma("unroll") for (int m = 0; m < 4; ++m) _Pragma("unroll") for (int n = 0; n < 2; ++n) \
            asm volatile("v_mfma_scale_f32_16x16x128_f8f6f4 %0, %1, %2, %0, %3, %3 op_sel_hi:[0,0,0]" : "+v"(acc[ai][bj][m][n]) : "v"(Bt##8[n]), "v"(At##8[m]), "v"(sc8)); } \
        else { _Pragma("unroll") for (int m = 0; m < 4; ++m) _Pragma("unroll") for (int n = 0; n < 2; ++n) _Pragma("unroll") for (int k = 0; k < 2; ++k) \
            acc[ai][bj][m][n] = __builtin_amdgcn_mfma_f32_16x16x32_bf16(Bt[n][k], At[m][k], acc[ai][bj][m][n], 0, 0, 0); } \
        __builtin_amdgcn_s_setprio(0); } while (0)
#define PG8_MMA0(ai, bj, At, Bt) do { __builtin_amdgcn_s_setprio(1); \
        if constexpr (F8) { _Pragma("unroll") for (int m = 0; m < 4; ++m) _Pragma("unroll") for (int n = 0; n < 2; ++n) \
            asm volatile("v_mfma_scale_f32_16x16x128_f8f6f4 %0, %1, %2, 0, %3, %3 op_sel_hi:[0,0,0]" : "=v"(acc[ai][bj][m][n]) : "v"(Bt##8[n]), "v"(At##8[m]), "v"(sc8)); } \
        else { _Pragma("unroll") for (int m = 0; m < 4; ++m) _Pragma("unroll") for (int n = 0; n < 2; ++n) { \
            acc[ai][bj][m][n] = __builtin_amdgcn_mfma_f32_16x16x32_bf16(Bt[n][0], At[m][0], (f32x4){0.f, 0.f, 0.f, 0.f}, 0, 0, 0); \
            acc[ai][bj][m][n] = __builtin_amdgcn_mfma_f32_16x16x32_bf16(Bt[n][1], At[m][1], acc[ai][bj][m][n], 0, 0, 0); } } \
        __builtin_amdgcn_s_setprio(0); } while (0)
#define PG8_WAIT_V(n) asm volatile("s_waitcnt vmcnt(" #n ")" ::: "memory")
#define PG8_WAIT_L(n) asm volatile("s_waitcnt lgkmcnt(" #n ")" ::: "memory")
#define PG8_BAR __builtin_amdgcn_s_barrier()
#define PG8_SCHED __builtin_amdgcn_sched_barrier(0)
    Unit cur, nxt; int ui = 0;
    if (!S.next(0, cur)) return;
    f32x4 acc[2][2][4][2];
    bf16x8 At[4][2], B0[2][2], B1[2][2];
    i32x8 At8[4], B08[2], B18[2];
    const int sc8 = 0x7F7F7F7F;
    const char* cA = (const char*)g.A + (size_t)cur.pm * tstep; const char* cB = (const char*)g.Bt + (size_t)cur.pn * tstep;
    S.a_ready(cur);
    if constexpr (SP2) {
        PG8_STAGE(PG8_SB(0, 0), cB, voffB); PG8_STAGE(PG8_SB(0, 1), cB + hstep, voffB); PG8_STAGE(PG8_SA(0, 0), cA, voffA); PG8_STAGE(PG8_SA(0, 1), cA + hstep, voffA);
        if (wr == 1) PG8_BAR;
        PG8_WAIT_V(2); PG8_BAR;
        PG8_STAGE(PG8_SB(1, 0), cB + kstep, voffB); PG8_STAGE(PG8_SA(1, 0), cA + kstep, voffA); PG8_STAGE(PG8_SB(1, 1), cB + hstep + kstep, voffB);
        PG8_WAIT_V(6); PG8_BAR;
    } else {
        PG8_STAGE(PG8_SB(0, 0), cB, voffB); PG8_STAGE(PG8_SA(0, 0), cA, voffA); PG8_STAGE(PG8_SB(0, 1), cB + hstep, voffB); PG8_STAGE(PG8_SA(0, 1), cA + hstep, voffA);
        if (wr == 1) PG8_BAR;
        PG8_WAIT_V(4); PG8_BAR;
        PG8_STAGE(PG8_SB(1, 0), cB + kstep, voffB); PG8_STAGE(PG8_SA(1, 0), cA + kstep, voffA); PG8_STAGE(PG8_SB(1, 1), cB + hstep + kstep, voffB);
        PG8_WAIT_V(6); PG8_BAR;
    }
    for (;;) {
        const bool has_next = S.next(ui + 1, nxt);
        const char* nA = has_next ? (const char*)g.A + (size_t)nxt.pm * tstep : cA; const char* nB = has_next ? (const char*)g.Bt + (size_t)nxt.pn * tstep : cB;
        static_assert(SP2, "the four-phase loop was removed: SP2 only");
#define PG8_KPAIR(MMAX) do { \
            PG8_LDB(B0, 0, 0); PG8_LDB(B1, 0, 1); PG8_SCHED; PG8_LDA(At, 0, 0); PG8_STAGE(PG8_SA(1, 1), a1 + hstep, voffA); \
            PG8_WAIT_V(8); PG8_WAIT_L(0); PG8_BAR; MMAX(0, 0, At, B0); MMAX(0, 1, At, B1); PG8_BAR; PG8_SCHED; \
            PG8_LDA(At, 0, 1); PG8_STAGE(PG8_SB(0, 0), b2, voffB); PG8_STAGE(PG8_SB(0, 1), b2 + hstep, voffB); PG8_STAGE(PG8_SA(0, 0), a2, voffA); \
            PG8_WAIT_V(8); PG8_WAIT_L(0); PG8_BAR; MMAX(1, 0, At, B0); MMAX(1, 1, At, B1); PG8_BAR; PG8_SCHED; \
            PG8_LDB(B0, 1, 0); PG8_LDB(B1, 1, 1); PG8_SCHED; PG8_LDA(At, 1, 0); PG8_STAGE(PG8_SA(0, 1), a2 + hstep, voffA); \
            PG8_WAIT_V(8); PG8_WAIT_L(0); PG8_BAR; PG8_MMA(0, 0, At, B0); PG8_MMA(0, 1, At, B1); PG8_BAR; PG8_SCHED; \
            PG8_LDA(At, 1, 1); PG8_STAGE(PG8_SB(1, 0), b3, voffB); PG8_STAGE(PG8_SB(1, 1), b3 + hstep, voffB); PG8_STAGE(PG8_SA(1, 0), a3, voffA); \
            PG8_WAIT_V(8); PG8_WAIT_L(0); PG8_BAR; PG8_MMA(1, 0, At, B0); PG8_MMA(1, 1, At, B1); PG8_BAR; PG8_SCHED; } while (0)
        {
            const char* a1 = cA + kstep; const char* a2 = cA + 2 * kstep; const char* b2 = cB + 2 * kstep; const char* a3 = a2 + kstep; const char* b3 = b2 + kstep;
            PG8_KPAIR(PG8_MMA0);
        }
        for (int t = 2; t < nt; t += 2) {
            const bool last = (t == nt - 2);
            const char* a1 = cA + (size_t)(t + 1) * kstep;
            const char* a2 = last ? nA : cA + (size_t)(t + 2) * kstep; const char* b2 = last ? nB : cB + (size_t)(t + 2) * kstep;
            const char* a3 = a2 + kstep; const char* b3 = b2 + kstep;
            if (last && has_next) S.a_ready(nxt);
            PG8_KPAIR(PG8_MMA);
        }
#undef PG8_KPAIR
        if constexpr (ALIGN_EPI) { if (wr == 0) PG8_BAR; }
        if constexpr (F8) asm volatile("s_nop 15\n\ts_nop 15" ::: "memory");
        if constexpr (!Epi::AFTER_DRAIN) { E(acc, cur, wr, wc, fr, fq); S.done(cur); }
        if (!has_next) break;
        cur = nxt; cA = nA; cB = nB; ++ui;
        if constexpr (ALIGN_EPI) { if (wr == 1) PG8_BAR; }
    }
    PG8_WAIT_V(0);
    if constexpr (!ALIGN_EPI) { if (wr == 0) PG8_BAR; }
    PG8_BAR;
    if constexpr (Epi::AFTER_DRAIN) { E.fused(acc, cur, wr, wc, fr, fq, lds, wid, lane); S.done(cur); }
#undef PG8_SA
#undef PG8_SB
#undef PG8_STAGE
#undef PG8_LDA
#undef PG8_LDB
#undef PG8_MMA
#undef PG8_MMA0
#undef PG8_LD32
#undef PG8_WAIT_V
#undef PG8_WAIT_L
#undef PG8_BAR
#undef PG8_SCHED
}
}

#define GAS __attribute__((address_space(1)))
#define LAS __attribute__((address_space(3)))
typedef unsigned short bf16;
typedef unsigned v4u __attribute__((ext_vector_type(4)));
typedef float f32x4 __attribute__((ext_vector_type(4)));
typedef short bf16x8 __attribute__((ext_vector_type(8)));
typedef GAS unsigned gu32;
typedef GAS unsigned long long gu64;
#define RLX_AGENT __ATOMIC_RELAXED, __HIP_MEMORY_SCOPE_AGENT
#define LDS_WAIT() asm volatile("s_waitcnt lgkmcnt(0)" ::: "memory")
#define VM_WAIT() asm volatile("s_waitcnt vmcnt(0)" ::: "memory")
__device__ __forceinline__ unsigned long long rt() { return __builtin_amdgcn_s_memrealtime(); }
__device__ __forceinline__ unsigned f2bf(float f) { unsigned u = __builtin_bit_cast(unsigned, f); return (u + 0x7fffu + ((u >> 16) & 1u)) >> 16; }
__device__ __forceinline__ unsigned pk2(float lo, float hi) { return f2bf(lo) | (f2bf(hi) << 16); }

#define XB_TMO      128
#define XB_XCNT(j)  (256  + 64 * (j))
#define XB_XSUB(j)  (1280 + 64 * (j))
#define XB_XGEN(j)  (2304 + 64 * (j))
#define XB_TOP      3328
#define XB_TOPGEN   3392
#define XCD_BAR_WORDS 3456
#define XB_SPIN_CAP (1u << 18)

__device__ __forceinline__ unsigned xb_ld(unsigned* p)              { return __hip_atomic_load(p, __ATOMIC_RELAXED, __HIP_MEMORY_SCOPE_AGENT); }
__device__ __forceinline__ unsigned xb_add(unsigned* p, unsigned v) { return __hip_atomic_fetch_add(p, v, __ATOMIC_RELAXED, __HIP_MEMORY_SCOPE_AGENT); }
__device__ __forceinline__ unsigned xb_xcc_id() { return (unsigned)__builtin_amdgcn_s_getreg((3 << 11) | 20) & 0xFu; }
#define XB_SPIN(cond, bar) do { unsigned _sp = 0; while (cond) { __builtin_amdgcn_s_sleep(1); \
    if ((++_sp & 255u) == 0u) { if (xb_ld(&(bar)[XB_TMO])) break; if (_sp > XB_SPIN_CAP) { atomicAdd(&(bar)[XB_TMO], 1u); break; } } } } while (0)

struct XcdBarrier {
    unsigned* bar; unsigned x;
    volatile LAS unsigned* st;
};

__device__ __forceinline__ XcdBarrier xcd_barrier_post(unsigned* bar, volatile LAS unsigned* st) {
    XcdBarrier b; b.bar = bar; b.x = xb_xcc_id(); b.st = st;
    if (threadIdx.x == 0) (void)xb_add(&bar[XB_XCNT(b.x)], 1u);
    return b;
}
__device__ __forceinline__ void xcd_barrier_complete(unsigned* bar, unsigned x, unsigned& nloc, unsigned& nx) {
    const unsigned G = gridDim.x * gridDim.y * gridDim.z;
    unsigned sum, cnt, mine, sp = 0u;
    for (;;) {
        sum = 0u; cnt = 0u; mine = 0u;
#pragma unroll
        for (unsigned j = 0; j < 16; ++j) { const unsigned c = xb_ld(&bar[XB_XCNT(j)]); sum += c; cnt += (c > 0u) ? 1u : 0u; mine = (j == x) ? c : mine; }
        if (sum == G) break;
        __builtin_amdgcn_s_sleep(1);
        if ((++sp & 255u) == 0u) { if (xb_ld(&bar[XB_TMO])) break; if (sp > XB_SPIN_CAP) { atomicAdd(&bar[XB_TMO], 1u); break; } }
    }
    nloc = mine > 0u ? mine : 1u; nx = cnt > 0u ? cnt : 1u;
}

__device__ __forceinline__ void xcd_barrier(const XcdBarrier& b) {
    asm volatile("s_waitcnt vmcnt(0)" ::: "memory");
    __syncthreads();
    if (threadIdx.x == 0) {
        unsigned* bar = b.bar;
        __builtin_amdgcn_s_waitcnt(0);
        unsigned nloc = b.st[0], nx = b.st[1];
        if (nloc == 0u) { xcd_barrier_complete(bar, b.x, nloc, nx); b.st[0] = nloc; b.st[1] = nx; }
        const unsigned old = xb_add(&bar[XB_XSUB(b.x)], 1u);
        const unsigned gen = old / nloc;
        if (old + 1u == (gen + 1u) * nloc) {
            __builtin_amdgcn_fence(__ATOMIC_RELEASE, "agent");
            asm volatile("s_waitcnt vmcnt(0)" ::: "memory");
            const unsigned og = xb_add(&bar[XB_TOP], 1u);
            const unsigned tg = og / nx;
            if (og + 1u == (tg + 1u) * nx) xb_add(&bar[XB_TOPGEN], 1u);
            else XB_SPIN(xb_ld(&bar[XB_TOPGEN]) == tg, bar);
            __builtin_amdgcn_fence(__ATOMIC_ACQUIRE, "agent");
            xb_add(&bar[XB_XGEN(b.x)], 1u);
            asm volatile("s_waitcnt vmcnt(0)" ::: "memory");
        } else {
            XB_SPIN(xb_ld(&bar[XB_XGEN(b.x)]) == gen, bar);
            __builtin_amdgcn_fence(__ATOMIC_ACQUIRE, "agent");
            asm volatile("s_waitcnt vmcnt(0)" ::: "memory");
        }
    }
    __syncthreads();
}

__device__ const double INV_FREQ[64] = {1.0, 0.8659643233600653, 0.7498942093324559, 0.6493816315762113, 0.5623413251903491, 0.4869675251658631, 0.4216965034285822, 0.3651741272548377, 0.31622776601683794, 0.27384196342643613, 0.23713737056616552, 0.2053525026457146, 0.1778279410038923, 0.1539926526059492, 0.1333521432163324, 0.11547819846894582, 0.1, 0.08659643233600653, 0.07498942093324558, 0.06493816315762113, 0.05623413251903491, 0.04869675251658631, 0.042169650342858224, 0.03651741272548377, 0.03162277660168379, 0.027384196342643614, 0.023713737056616554, 0.02053525026457146, 0.01778279410038923, 0.01539926526059492, 0.01333521432163324, 0.011547819846894581, 0.01, 0.008659643233600654, 0.007498942093324558, 0.006493816315762113, 0.005623413251903491, 0.004869675251658631, 0.004216965034285823, 0.003651741272548377, 0.0031622776601683794, 0.0027384196342643613, 0.0023713737056616554, 0.002053525026457146, 0.0017782794100389228, 0.001539926526059492, 0.001333521432163324, 0.0011547819846894581, 0.001, 0.0008659643233600654, 0.0007498942093324559, 0.0006493816315762113, 0.0005623413251903491, 0.0004869675251658631, 0.00042169650342858224, 0.0003651741272548377, 0.00031622776601683794, 0.0002738419634264361, 0.00023713737056616554, 0.0002053525026457146, 0.00017782794100389227, 0.0001539926526059492, 0.0001333521432163324, 0.00011547819846894582};
#define PG8_SP2 true
#define PG8_ALIGN true
constexpr int NWAVES = 8;
constexpr int BATCH = 4, SEQ = 4096, D = 4096, FF = 11008, M = BATCH * SEQ, NPROJ = 12288, NPROJ_ALL = 12296, CH = 128, NCH = SEQ / CH;
constexpr int RH = 8, RDK = 128, RDV = 256, MH = 4, MDK = 256, MDV = 512, MVR = 528  ;
constexpr float NORM_EPS = 1e-6f;
constexpr int C_RQ = 0, C_RK = 1024, C_RV = 2048, C_RG = 4096, C_MQ = 6144, C_MK = 7168, C_MV = 8192, C_MO = 10240;
constexpr size_t MiB = 1u << 20;
constexpr size_t WS_CTL = 0, CTL_ZERO_BYTES = 32768;
constexpr size_t WS_ROT = 1 * MiB;
constexpr size_t WS_GI = 3 * MiB;
constexpr size_t WS_LF = WS_GI + 256 * 1024;
constexpr size_t WS_WG8 = WS_LF + 256 * 1024;
constexpr size_t WS_CHS = WS_WG8 + 128 * 1024;
constexpr size_t WS_MP = WS_CHS + 4096;
constexpr size_t WS_ST_R = 8 * MiB;
constexpr size_t WS_ST_M = 72 * MiB;
constexpr size_t WS_WGU1 = 8 * MiB;
constexpr size_t WS_WD1 = 180 * MiB;
constexpr size_t WS_WIN = 266 * MiB;
constexpr size_t WS_WOUT = 362 * MiB;
constexpr size_t WS_WGU2 = 394 * MiB;
constexpr size_t WS_WD2 = 566 * MiB;
constexpr size_t WS_XN = 652 * MiB;
constexpr size_t WS_BIG = 780 * MiB;
constexpr int GU8 = 18;
constexpr size_t WS_XN8 = WS_BIG + 192 * MiB;
constexpr size_t WS_RES = 1164 * MiB;
constexpr size_t WS_END = 1292 * MiB;
static_assert(WS_ST_M + (size_t)16 * 32 * MVR * MDK * 2 <= WS_WIN && WS_ST_R + (size_t)32 * 32 * RDV * RDK * 2 <= WS_ST_M, "state overlay");
static_assert(WS_BIG + (size_t)M * NPROJ * 2 <= WS_END && WS_XN8 >= WS_BIG + (size_t)M * FF && WS_XN8 + (size_t)M * D <= WS_RES, "ws map");
constexpr int CW_BAR = 4096;
constexpr int RING_OFF = 0, RING_BYTES = 131072;
constexpr int SM_OFF = 139264;
constexpr int LDSCTL_OFF = 141312, MISC_OFF = LDSCTL_OFF + 320;
constexpr int LDS_BYTES = 147456;
static_assert(MISC_OFF + 128 <= LDS_BYTES, "LDS map");

typedef short s16x4 __attribute__((ext_vector_type(4)));
typedef float f32x2 __attribute__((ext_vector_type(2)));
typedef unsigned v2u __attribute__((ext_vector_type(2)));
struct Frame {
    LAS unsigned char* lds;
    volatile LAS unsigned* MISC;
    gu32* ctl;
    int tid, lane, wave;
    int vcu, G;
    const float* in[19]; float* out; unsigned char* ws;
};
__device__ __forceinline__ float wave_sum(float v) {
#pragma unroll
    for (int o = 1; o < 64; o <<= 1) v += __shfl_xor(v, o);
    return v;
}
__device__ __forceinline__ float bf2f(short s) { return __builtin_bit_cast(float, ((unsigned)(unsigned short)s) << 16); }
__device__ __forceinline__ float bflo(unsigned w) { return __builtin_bit_cast(float, w << 16); }
__device__ __forceinline__ float bfhi(unsigned w) { return __builtin_bit_cast(float, w & 0xffff0000u); }
__device__ __forceinline__ size_t blk_off(int r, int k, int nkt) { return ((size_t)((r >> 8) * nkt + (k >> 6)) * 256 + (r & 255)) * 64 + (k & 63); }

__device__ __forceinline__ const bf16* head_ptr(const unsigned char* ws, int seg_start, int hw, int H, int b, int h) { return (const bf16*)(ws + WS_BIG) + (size_t)seg_start * M + (size_t)(b * H + h) * SEQ * hw; }
__device__ __forceinline__ void transpose_item(const float* W, int ldw, int k0, int n0, bf16* WT, int nr0, int K, LAS float* scr, int lane) {
    f32x4 v[8];
#pragma unroll
    for (int i = 0; i < 8; ++i) { const int kk = 8 * i + (lane >> 3); v[i] = __builtin_nontemporal_load((const GAS f32x4*)(W + (size_t)(k0 + kk) * ldw + n0 + 4 * (lane & 7))); }
#pragma unroll
    for (int i = 0; i < 8; ++i) { const int kk = 8 * i + (lane >> 3); LAS float* p = scr + kk * 33 + 4 * (lane & 7); p[0] = v[i].x; p[1] = v[i].y; p[2] = v[i].z; p[3] = v[i].w; }
    LDS_WAIT(); asm volatile("" ::: "memory");
    const int c = lane & 7;
#pragma unroll
    for (int j = 0; j < 4; ++j) { const int n = (lane >> 3) + 8 * j; const LAS float* s = scr + (8 * c) * 33 + n;
        v4u o; o.x = pk2(s[0 * 33], s[1 * 33]); o.y = pk2(s[2 * 33], s[3 * 33]); o.z = pk2(s[4 * 33], s[5 * 33]); o.w = pk2(s[6 * 33], s[7 * 33]);
        *(GAS v4u*)(WT + blk_off(nr0 + n, k0 + 8 * c, K >> 6)) = o; }
    LDS_WAIT(); asm volatile("" ::: "memory");
}
__device__ __forceinline__ void transpose_item8(const float* W, int ldw, int k0, int n0, unsigned char* WT8, int nr0, int K, LAS float* scr, int lane, float sc) {
    f32x4 v[8];
#pragma unroll
    for (int i = 0; i < 8; ++i) { const int kk = 8 * i + (lane >> 3); v[i] = __builtin_nontemporal_load((const GAS f32x4*)(W + (size_t)(k0 + kk) * ldw + n0 + 4 * (lane & 7))); }
#pragma unroll
    for (int i = 0; i < 8; ++i) { const int kk = 8 * i + (lane >> 3); LAS float* p = scr + kk * 33 + 4 * (lane & 7); p[0] = v[i].x; p[1] = v[i].y; p[2] = v[i].z; p[3] = v[i].w; }
    LDS_WAIT(); asm volatile("" ::: "memory");
    const int c = lane & 3;
#pragma unroll
    for (int j = 0; j < 2; ++j) { const int n = (lane >> 2) + 16 * j; const LAS float* s = scr + (16 * c) * 33 + n;
        v4u o;
        o.x = pg8::pack4_fp8(sc * s[0 * 33], sc * s[1 * 33], sc * s[2 * 33], sc * s[3 * 33]); o.y = pg8::pack4_fp8(sc * s[4 * 33], sc * s[5 * 33], sc * s[6 * 33], sc * s[7 * 33]);
        o.z = pg8::pack4_fp8(sc * s[8 * 33], sc * s[9 * 33], sc * s[10 * 33], sc * s[11 * 33]); o.w = pg8::pack4_fp8(sc * s[12 * 33], sc * s[13 * 33], sc * s[14 * 33], sc * s[15 * 33]);
        *(GAS v4u*)(WT8 + pg8::blk8_off(nr0 + n, k0 + 16 * c, K >> 7)) = o; }
    LDS_WAIT(); asm volatile("" ::: "memory");
}
__device__ __forceinline__ void transpose_plain8(const float* W, int K, int N, int ldw, unsigned char* WT8, LAS float* scr, int item, int lane, float sc) {
    const int nblk = N / 32, kb = item / nblk, nb = item % nblk;
    transpose_item8(W, ldw, 64 * kb, 32 * nb, WT8, 32 * nb, K, scr, lane, sc);
}
__device__ __forceinline__ void transpose_gu8(const float* W, int half, unsigned char* WT8, LAS float* scr, int kb, int n0, int lane, float sc) {
    transpose_item8(W, FF, 64 * kb, n0, WT8, (n0 >> 7) * 256 + half * 128 + (n0 & 127), D, scr, lane, sc);
}
__device__ __forceinline__ void transpose_plain(const float* W, int K, int N, int ldw, bf16* WT, LAS float* scr, int item, int lane) {
    const int nblk = N / 32, kb = item / nblk, nb = item % nblk;
    transpose_item(W, ldw, 64 * kb, 32 * nb, WT, 32 * nb, K, scr, lane);
}
__device__ __forceinline__ void transpose_gu(const float* W, int half, bf16* WT, LAS float* scr, int item, int lane) {
    const int nblk = FF / 32, kb = item / nblk, nb = item % nblk, n0 = 32 * nb;
    transpose_item(W, FF, 64 * kb, n0, WT, (n0 >> 7) * 256 + half * 128 + (n0 & 127), D, scr, lane);
}
struct TItem { const float* W; bf16* WT; int ldw, k0, n0, nr0, K; };
__device__ __forceinline__ TItem titem_plain(const float* W, int K, int N, int ldw, bf16* WT, int item) {
    const int nblk = N / 32, kb = item / nblk, nb = item % nblk; TItem t; t.W = W; t.WT = WT; t.ldw = ldw; t.k0 = 64 * kb; t.n0 = 32 * nb; t.nr0 = 32 * nb; t.K = K; return t; }
__device__ __forceinline__ TItem titem_gu(const float* W, int half, bf16* WT, int item) {
    const int nblk = FF / 32, kb = item / nblk, nb = item % nblk, n0 = 32 * nb; TItem t; t.W = W; t.WT = WT; t.ldw = FF; t.k0 = 64 * kb; t.n0 = n0; t.nr0 = (n0 >> 7) * 256 + half * 128 + (n0 & 127); t.K = D; return t; }
__device__ __forceinline__ void titem_load(const TItem& t, f32x4 (&v)[8], int lane) {
#pragma unroll
    for (int i = 0; i < 8; ++i) { const int kk = 8 * i + (lane >> 3); v[i] = *(const GAS f32x4*)(t.W + (size_t)(t.k0 + kk) * t.ldw + t.n0 + 4 * (lane & 7)); }
}
__device__ __forceinline__ void titem_process(const TItem& t, const f32x4 (&v)[8], LAS float* scr, int lane) {
#pragma unroll
    for (int i = 0; i < 8; ++i) { const int kk = 8 * i + (lane >> 3); LAS float* p = scr + kk * 33 + 4 * (lane & 7); p[0] = v[i].x; p[1] = v[i].y; p[2] = v[i].z; p[3] = v[i].w; }
    LDS_WAIT(); asm volatile("" ::: "memory");
    const int c = lane & 7;
#pragma unroll
    for (int j = 0; j < 4; ++j) { const int n = (lane >> 3) + 8 * j; const LAS float* s = scr + (8 * c) * 33 + n;
        v4u o; o.x = pk2(s[0 * 33], s[1 * 33]); o.y = pk2(s[2 * 33], s[3 * 33]); o.z = pk2(s[4 * 33], s[5 * 33]); o.w = pk2(s[6 * 33], s[7 * 33]);
        *(GAS v4u*)(t.WT + blk_off(t.nr0 + n, t.k0 + 8 * c, t.K >> 6)) = o; }
    LDS_WAIT(); asm volatile("" ::: "memory");
}
template <int MODE>
__device__ __forceinline__ void norm_row(const float* xrow, const float* g, bf16* obase, int row, float* frow, const LAS float* wg, float (&gd)[8], int lane) {
    const GAS f32x4* xr = (const GAS f32x4*)xrow + lane; const GAS f32x4* gr = (const GAS f32x4*)g + lane;
    f32x4 v[16]; float s = 0.f;
#pragma unroll
    for (int j = 0; j < 16; ++j) { v[j] = xr[64 * j]; s += (v[j].x * v[j].x + v[j].y * v[j].y) + (v[j].z * v[j].z + v[j].w * v[j].w); }
    const float rstd = 1.0f / sqrtf(wave_sum(s) * (1.0f / D) + NORM_EPS);
#pragma unroll
    for (int hh = 0; hh < 8; ++hh) gd[hh] = 0.f;
#pragma unroll
    for (int j = 0; j < 16; ++j) {
        const f32x4 gv = gr[64 * j]; const f32x4 y = v[j] * rstd * gv;
        if (MODE == 2) { ((GAS f32x4*)frow + lane)[64 * j] = y; }
        else { v2u o; o.x = pk2(y.x, y.y); o.y = pk2(y.z, y.w); *(GAS v2u*)(obase + blk_off(row, 4 * lane + 256 * j, D >> 6)) = o; }
        if (MODE == 1) {
#pragma unroll
            for (int hh = 0; hh < 8; ++hh) { const f32x4 w = *(const LAS f32x4*)(wg + hh * D + 4 * lane + 256 * j); gd[hh] += (y.x * w.x + y.y * w.y) + (y.z * w.z + y.w * w.w); }
            asm volatile("" ::: "memory");
        }
    }
}
template <int MODE, bool X8 = false>
__device__ __forceinline__ void norm_row_bf(const bf16* xrow, const float* g, bf16* obase, int row, float* frow, const LAS float* wg, float (&gd)[8], int lane, unsigned char* o8 = nullptr) {
    const GAS v4u* xr = (const GAS v4u*)xrow + lane; const GAS f32x4* gr = (const GAS f32x4*)g + 2 * lane;
    v4u xv[8]; float s = 0.f;
#pragma unroll
    for (int j = 0; j < 8; ++j) { xv[j] = xr[64 * j];
        const float a0 = bflo(xv[j].x), a1 = bfhi(xv[j].x), a2 = bflo(xv[j].y), a3 = bfhi(xv[j].y), a4 = bflo(xv[j].z), a5 = bfhi(xv[j].z), a6 = bflo(xv[j].w), a7 = bfhi(xv[j].w);
        s += ((a0 * a0 + a1 * a1) + (a2 * a2 + a3 * a3)) + ((a4 * a4 + a5 * a5) + (a6 * a6 + a7 * a7)); }
    const float rstd = 1.0f / sqrtf(wave_sum(s) * (1.0f / D) + NORM_EPS);
#pragma unroll
    for (int hh = 0; hh < 8; ++hh) gd[hh] = 0.f;
#pragma unroll
    for (int j = 0; j < 8; ++j) {
        const f32x4 g0 = gr[128 * j], g1 = gr[128 * j + 1];
        const f32x4 y0 = (f32x4){bflo(xv[j].x), bfhi(xv[j].x), bflo(xv[j].y), bfhi(xv[j].y)} * rstd * g0, y1 = (f32x4){bflo(xv[j].z), bfhi(xv[j].z), bflo(xv[j].w), bfhi(xv[j].w)} * rstd * g1;
        if (MODE == 2) { GAS f32x4* fo = (GAS f32x4*)frow + 2 * (lane + 64 * j); fo[0] = y0; fo[1] = y1; }
        else { v4u o; o.x = pk2(y0.x, y0.y); o.y = pk2(y0.z, y0.w); o.z = pk2(y1.x, y1.y); o.w = pk2(y1.z, y1.w); *(GAS v4u*)(obase + blk_off(row, 8 * (lane + 64 * j), D >> 6)) = o; }
        if (X8) { v2u o; o.x = pg8::pack4_fp8(pg8::F8_X_SCALE * y0.x, pg8::F8_X_SCALE * y0.y, pg8::F8_X_SCALE * y0.z, pg8::F8_X_SCALE * y0.w); o.y = pg8::pack4_fp8(pg8::F8_X_SCALE * y1.x, pg8::F8_X_SCALE * y1.y, pg8::F8_X_SCALE * y1.z, pg8::F8_X_SCALE * y1.w);
            *(GAS v2u*)(o8 + pg8::blk8_off(row, 8 * (lane + 64 * j), D >> 7)) = o; }
        if (MODE == 1) {
#pragma unroll
            for (int hh = 0; hh < 8; ++hh) { const LAS f32x4* wp = (const LAS f32x4*)(wg + hh * D + 8 * (lane + 64 * j)); const f32x4 w0 = wp[0], w1 = wp[1];
                gd[hh] += ((y0.x * w0.x + y0.y * w0.y) + (y0.z * w0.z + y0.w * w0.w)) + ((y1.x * w1.x + y1.y * w1.y) + (y1.z * w1.z + y1.w * w1.w)); }
            asm volatile("" ::: "memory");
        }
    }
}
__device__ __forceinline__ float log_sigmoid(float x) { return fminf(x, 0.f) - log1pf(__expf(-fabsf(x))); }

#define MFMA16(a, b, c) __builtin_amdgcn_mfma_f32_16x16x32_bf16((a), (b), (c), 0, 0, 0)
__device__ __forceinline__ bf16x8 tr_frag(const LAS unsigned char* base, int pitch, int k0, int n0, int lane) {
    const int g = lane >> 4, q = (lane & 15) >> 2, p = lane & 3;
    const LAS unsigned char* a = base + ((k0 + 8 * g + q) * pitch + n0 + 4 * p) * 2;
    const s16x4 lo = __builtin_amdgcn_ds_read_tr16_b64_v4i16((LAS s16x4*)a);
    const s16x4 hi = __builtin_amdgcn_ds_read_tr16_b64_v4i16((LAS s16x4*)(a + 8 * pitch));
    bf16x8 r; r[0] = lo[0]; r[1] = lo[1]; r[2] = lo[2]; r[3] = lo[3]; r[4] = hi[0]; r[5] = hi[1]; r[6] = hi[2]; r[7] = hi[3]; return r;
}
constexpr int PV_PITCH = 136;
constexpr int VS_BYTES = 128 * PV_PITCH * 2;
__device__ __forceinline__ void stage_v(LAS unsigned char* dst, const bf16* hp, int pitch, int pos0, int col, int tid) {
#pragma unroll
    for (int it = 0; it < 4; ++it) { const int p = tid + 512 * it, j = p >> 4, ch = p & 15;
        const v4u x = *(const GAS v4u*)(hp + (size_t)(pos0 + j) * pitch + col + 8 * ch);
        *(LAS v4u*)(dst + (j * PV_PITCH + 8 * ch) * 2) = x; }
}
__device__ __forceinline__ void stage_rot(LAS unsigned char* dst, const bf16* hp, const float* rot, int pos0, float scale, float lgk, int tid) {
    const int j = tid >> 2, q = tid & 3;
    const bf16* p = hp + (size_t)(pos0 + j) * 128 + 16 * q;
    const bf16x8 x1a = *(const GAS bf16x8*)p, x1b = *(const GAS bf16x8*)(p + 8), x2a = *(const GAS bf16x8*)(p + 64), x2b = *(const GAS bf16x8*)(p + 72);
    const GAS f32x4* rt = (const GAS f32x4*)(rot + ((size_t)(pos0 + j) * 64 + 16 * q) * 2);
    f32x4 cs[8];
#pragma unroll
    for (int i = 0; i < 8; ++i) cs[i] = rt[i];
    const float mul = scale * (lgk != 0.f ? __expf(lgk * (float)(127 - j)) : 1.0f);
    float y1[16], y2[16];
#pragma unroll
    for (int e = 0; e < 16; ++e) { const float a = bf2f(e < 8 ? x1a[e] : x1b[e - 8]), b = bf2f(e < 8 ? x2a[e] : x2b[e - 8]);
        const float c = cs[e >> 1][(e & 1) * 2], s = cs[e >> 1][(e & 1) * 2 + 1];
        y1[e] = (a * c - b * s) * mul; y2[e] = (a * s + b * c) * mul; }
    LAS unsigned char* o = dst + (j * PV_PITCH + 16 * q) * 2;
    v4u w;
    w.x = pk2(y1[0], y1[1]); w.y = pk2(y1[2], y1[3]); w.z = pk2(y1[4], y1[5]); w.w = pk2(y1[6], y1[7]); *(LAS v4u*)o = w;
    w.x = pk2(y1[8], y1[9]); w.y = pk2(y1[10], y1[11]); w.z = pk2(y1[12], y1[13]); w.w = pk2(y1[14], y1[15]); *(LAS v4u*)(o + 16) = w;
    w.x = pk2(y2[0], y2[1]); w.y = pk2(y2[2], y2[3]); w.z = pk2(y2[4], y2[5]); w.w = pk2(y2[6], y2[7]); *(LAS v4u*)(o + 128) = w;
    w.x = pk2(y2[8], y2[9]); w.y = pk2(y2[10], y2[11]); w.z = pk2(y2[12], y2[13]); w.w = pk2(y2[14], y2[15]); *(LAS v4u*)(o + 144) = w;
}
constexpr int MK_PITCH = 264;
__device__ __forceinline__ void stage_conv(LAS unsigned char* dst, const bf16* hp, const float* cw, const float* cb, int t0, int cch, float scale, const LAS float* rw, int tid) {
    const int dch = tid & 31, jg = tid >> 5, d0 = 8 * dch;
    float w[4][8], bias[8];
#pragma unroll
    for (int k = 0; k < 4; ++k) { const f32x4 a = *(const GAS f32x4*)(cw + k * 2048 + cch + d0), b = *(const GAS f32x4*)(cw + k * 2048 + cch + d0 + 4);
        w[k][0] = a.x; w[k][1] = a.y; w[k][2] = a.z; w[k][3] = a.w; w[k][4] = b.x; w[k][5] = b.y; w[k][6] = b.z; w[k][7] = b.w; }
    { const f32x4 a = *(const GAS f32x4*)(cb + cch + d0), b = *(const GAS f32x4*)(cb + cch + d0 + 4);
        bias[0] = a.x; bias[1] = a.y; bias[2] = a.z; bias[3] = a.w; bias[4] = b.x; bias[5] = b.y; bias[6] = b.z; bias[7] = b.w; }
    bf16x8 x[11];
#pragma unroll
    for (int r = 0; r < 11; ++r) { const int t = t0 + 8 * jg + r - 3;
        if (t >= 0) x[r] = *(const GAS bf16x8*)(hp + (size_t)t * 256 + d0); else x[r] = (bf16x8){0, 0, 0, 0, 0, 0, 0, 0}; }
#pragma unroll
    for (int jj = 0; jj < 8; ++jj) {
        const float rs = scale * (rw ? rw[8 * jg + jj] : 1.0f);
        float y[8];
#pragma unroll
        for (int e = 0; e < 8; ++e) { float a = bias[e];
#pragma unroll
            for (int k = 0; k < 4; ++k) a += w[k][e] * bf2f(x[jj + k][e]);
            y[e] = a * __builtin_amdgcn_rcpf(1.0f + __expf(-a)) * rs; }
        v4u o; o.x = pk2(y[0], y[1]); o.y = pk2(y[2], y[3]); o.z = pk2(y[4], y[5]); o.w = pk2(y[6], y[7]);
        *(LAS v4u*)(dst + ((8 * jg + jj) * MK_PITCH + d0) * 2) = o; }
}
__device__ __forceinline__ void gate_scan(const float* GI, const float* LF, int row0, int h, float mprev, LAS float* sA, LAS float* sB, LAS float* sG, float& amax, float& blast, int lane) {
    const int r = row0 + 2 * lane;
    const float f0 = LF[(size_t)r * 4 + h], f1 = LF[(size_t)(r + 1) * 4 + h], i0 = GI[(size_t)r * 4 + h], i1 = GI[(size_t)(r + 1) * 4 + h];
    const float s = f0 + f1; float incl = s;
#pragma unroll
    for (int o = 1; o < 64; o <<= 1) { const float t = __shfl_up(incl, o); if (lane >= o) incl += t; }
    const float b0 = (incl - s) + f0, b1 = b0 + f1, a0 = i0 - b0, a1 = i1 - b1;
    float cm = fmaxf(a0, a1);
#pragma unroll
    for (int o = 1; o < 64; o <<= 1) { const float t = __shfl_up(cm, o); if (lane >= o) cm = fmaxf(cm, t); }
    float pe = __shfl_up(cm, 1); if (lane == 0) pe = -__builtin_inff();
    const float g0 = fmaxf(fmaxf(mprev, pe), a0), g1 = fmaxf(g0, a1);
    sA[2 * lane] = a0; sA[2 * lane + 1] = a1; sB[2 * lane] = b0; sB[2 * lane + 1] = b1; sG[2 * lane] = g0; sG[2 * lane + 1] = g1;
    amax = __shfl(cm, 63); blast = __shfl(b1, 63);
}
__device__ __forceinline__ float ret_log_gamma(int h) { return log1pf(-exp2f(-5.0f - (float)h)); }

template <bool ML>
__device__ __forceinline__ void phaseA_unit(Frame& F, int u) {
    constexpr int H = ML ? MH : RH, DK = ML ? MDK : RDK, DV = ML ? MDV : RDV, NSL = DV / 128, DT = DK / 128, VR = ML ? MVR : RDV, PK = ML ? MK_PITCH : PV_PITCH;
    constexpr int KB = 128 * PK * 2;
    int tid_ = F.tid; asm volatile("" : "+v"(tid_));
    const int b = u / (H * NCH), h = (u / NCH) % H, c = u % NCH, row0 = b * SEQ + c * CH, tid = tid_, lane = tid & 63, wave = F.wave;
    const bf16* proj = (const bf16*)(F.ws + WS_BIG);
    LAS unsigned char* kreg = F.lds; LAS unsigned char* vreg = F.lds + KB;
    LAS float* sA = (LAS float*)(F.lds + SM_OFF); LAS float* sB = sA + 128; LAS float* sG = sA + 256; LAS float* sW = sA + 384;
    bf16* st = (bf16*)(F.ws + (ML ? WS_ST_M : WS_ST_R)) + (size_t)u * VR * DK;
    const bf16* vhp = ML ? head_ptr(F.ws, C_MV, MDV, MH, b, h) : head_ptr(F.ws, C_RV, RDV, RH, b, h);
    v4u vpre[4];
#define PA_LOAD_V(sl_) do { _Pragma("unroll") for (int it = 0; it < 4; ++it) { const int p_ = tid + 512 * it, j_ = p_ >> 4, ch_ = p_ & 15; vpre[it] = *(const GAS v4u*)(vhp + (size_t)(c * CH + j_) * DV + 128 * (sl_) + 8 * ch_); } } while (0)
#define PA_WRITE_V() do { _Pragma("unroll") for (int it = 0; it < 4; ++it) { const int p_ = tid + 512 * it, j_ = p_ >> 4, ch_ = p_ & 15; *(LAS v4u*)(vreg + (j_ * PV_PITCH + 8 * ch_) * 2) = vpre[it]; } } while (0)
    PA_LOAD_V(0);
    if (ML) {
        if (wave == 0) { float amax, blast; gate_scan((const float*)(F.ws + WS_GI), (const float*)(F.ws + WS_LF), row0, h, -__builtin_inff(), sA, sB, sG, amax, blast, lane);
            sW[2 * lane] = __expf(sA[2 * lane] - amax); sW[2 * lane + 1] = __expf(sA[2 * lane + 1] - amax);
            if (lane == 0) { float* chs = (float*)(F.ws + WS_CHS) + 2 * u; chs[0] = amax; chs[1] = blast; } }
        __syncthreads();
        stage_conv(kreg, head_ptr(F.ws, C_MK, MDK, MH, b, h), F.in[7], F.in[8], c * CH, 1024 + MDK * h, 0.0625f, sW, tid);
    } else {
        stage_rot(kreg, head_ptr(F.ws, C_RK, RDK, RH, b, h), (const float*)(F.ws + WS_ROT), c * CH, 0.08838834764831845f, ret_log_gamma(h), tid);
    }
    const int g = lane >> 4, fr = lane & 15;
    const bf16x8 ones = (fr == 0) ? (bf16x8){0x3F80, 0x3F80, 0x3F80, 0x3F80, 0x3F80, 0x3F80, 0x3F80, 0x3F80} : (bf16x8){0, 0, 0, 0, 0, 0, 0, 0};
    for (int sl = 0; sl < NSL; ++sl) {
        PA_WRITE_V();
        __syncthreads();
        if (sl + 1 < NSL) PA_LOAD_V(sl + 1);
        f32x4 acc[DT][8], accn[DT];
#pragma unroll
        for (int dt = 0; dt < DT; ++dt) { accn[dt] = (f32x4){0.f, 0.f, 0.f, 0.f};
#pragma unroll
            for (int vt = 0; vt < 8; ++vt) acc[dt][vt] = (f32x4){0.f, 0.f, 0.f, 0.f}; }
#pragma unroll
        for (int ks = 0; ks < 4; ++ks) {
            bf16x8 af[DT];
#pragma unroll
            for (int dt = 0; dt < DT; ++dt) af[dt] = tr_frag(kreg, PK, 32 * ks, 16 * (wave * DT + dt), lane);
#pragma unroll
            for (int vt = 0; vt < 8; ++vt) { const bf16x8 bfv = tr_frag(vreg, PV_PITCH, 32 * ks, 16 * vt, lane);
#pragma unroll
                for (int dt = 0; dt < DT; ++dt) acc[dt][vt] = MFMA16(af[dt], bfv, acc[dt][vt]); }
            if (ML && sl == 0) {
#pragma unroll
                for (int dt = 0; dt < DT; ++dt) accn[dt] = MFMA16(af[dt], ones, accn[dt]); }
        }
#pragma unroll
        for (int dt = 0; dt < DT; ++dt) {
            const int d = 16 * (wave * DT + dt) + 4 * g;
#pragma unroll
            for (int vt = 0; vt < 8; ++vt) { const f32x4 a = acc[dt][vt]; v2u o; o.x = pk2(a[0], a[1]); o.y = pk2(a[2], a[3]);
                *(GAS v2u*)(st + (size_t)(128 * sl + 16 * vt + fr) * DK + d) = o; }
            if (ML && sl == 0 && fr == 0) { const f32x4 a = accn[dt]; v2u o; o.x = pk2(a[0], a[1]); o.y = pk2(a[2], a[3]); *(GAS v2u*)(st + (size_t)MDV * DK + d) = o; }
        }
        __syncthreads();
    }
#undef PA_LOAD_V
#undef PA_WRITE_V
}
__device__ __forceinline__ void phaseB(Frame& F) {
    const size_t gt = (size_t)F.vcu * 512 + F.tid, NT = (size_t)F.G * 512;
    for (size_t it = gt; it < (size_t)32 * RDV * 16; it += NT) {
        const int bh = (int)(it >> 12), rem = (int)(it & 4095), v = rem >> 4, dch = rem & 15, h = bh & 7;
        const float decay = __expf(ret_log_gamma(h) * 128.0f);
        bf16* p = (bf16*)(F.ws + WS_ST_R) + ((size_t)bh * NCH * RDV + v) * RDK + 8 * dch;
        float run[8];
#pragma unroll
        for (int e = 0; e < 8; ++e) run[e] = 0.f;
#pragma unroll 16
        for (int c = 0; c < NCH; ++c) { GAS v4u* q = (GAS v4u*)(p + (size_t)c * RDV * RDK); const v4u x = *q;
            v4u o; o.x = pk2(run[0], run[1]); o.y = pk2(run[2], run[3]); o.z = pk2(run[4], run[5]); o.w = pk2(run[6], run[7]); *q = o;
            run[0] = run[0] * decay + bflo(x.x); run[1] = run[1] * decay + bfhi(x.x); run[2] = run[2] * decay + bflo(x.y); run[3] = run[3] * decay + bfhi(x.y);
            run[4] = run[4] * decay + bflo(x.z); run[5] = run[5] * decay + bfhi(x.z); run[6] = run[6] * decay + bflo(x.w); run[7] = run[7] * decay + bfhi(x.w); }
    }
    for (size_t it = gt; it < (size_t)16 * 513 * 32; it += NT) {
        const int bh = (int)(it / (513 * 32)), rem = (int)(it % (513 * 32)), v = rem >> 5, dch = rem & 31;
        bf16* p = (bf16*)(F.ws + WS_ST_M) + ((size_t)bh * NCH * MVR + v) * MDK + 8 * dch;
        const float* chs = (const float*)(F.ws + WS_CHS) + (size_t)bh * NCH * 2; float* mp = (float*)(F.ws + WS_MP) + (size_t)bh * NCH;
        float run[8], m = 0.f;
#pragma unroll
        for (int e = 0; e < 8; ++e) run[e] = 0.f;
#pragma unroll 16
        for (int c = 0; c < NCH; ++c) { GAS v4u* q = (GAS v4u*)(p + (size_t)c * MVR * MDK); const v4u x = *q;
            const float am = chs[2 * c], bl = chs[2 * c + 1], gl = fmaxf(m, am), ws_ = __expf(m - gl), wd = __expf(am - gl);
            if (rem == 0) mp[c] = m;
            v4u o; o.x = pk2(run[0], run[1]); o.y = pk2(run[2], run[3]); o.z = pk2(run[4], run[5]); o.w = pk2(run[6], run[7]); *q = o;
            run[0] = run[0] * ws_ + wd * bflo(x.x); run[1] = run[1] * ws_ + wd * bfhi(x.x); run[2] = run[2] * ws_ + wd * bflo(x.y); run[3] = run[3] * ws_ + wd * bfhi(x.y);
            run[4] = run[4] * ws_ + wd * bflo(x.z); run[5] = run[5] * ws_ + wd * bfhi(x.z); run[6] = run[6] * ws_ + wd * bflo(x.w); run[7] = run[7] * ws_ + wd * bfhi(x.w);
            m = bl + gl; }
    }
}
template <bool ML>
__device__ __forceinline__ void phaseC_unit(Frame& F, int u) {
    constexpr int H = ML ? MH : RH, DK = ML ? MDK : RDK, DV = ML ? MDV : RDV, NSL = DV / 128, KS = DK / 32, VR = ML ? MVR : RDV, PK = ML ? MK_PITCH : PV_PITCH;
    constexpr int KB = 128 * PK * 2, NSTL = (128 * DK * 2) / (512 * 16);
    int tid_ = F.tid; asm volatile("" : "+v"(tid_));
    const int b = u / (H * NCH), h = (u / NCH) % H, c = u % NCH, row0 = b * SEQ + c * CH, tid = tid_, lane = tid & 63, wave = F.wave;
    const bf16* proj = (const bf16*)(F.ws + WS_BIG);
    bf16* mixed = (bf16*)(F.ws + WS_XN);
    LAS unsigned char* kreg = F.lds; LAS unsigned char* qreg = F.lds + KB; LAS unsigned char* vreg = F.lds + KB;
    LAS unsigned char* oreg = F.lds + KB + wave * (16 * PV_PITCH * 2); LAS unsigned char* preg = F.lds + KB + VS_BYTES + wave * (16 * PV_PITCH * 2);
    LAS float* sA = (LAS float*)(F.lds + SM_OFF); LAS float* sB = sA + 128; LAS float* sG = sA + 256; LAS float* sR = sA + 384 + 16 * wave;
    const bf16* st = (const bf16*)(F.ws + (ML ? WS_ST_M : WS_ST_R)) + (size_t)u * VR * DK;
    const int g = lane >> 4, fr = lane & 15, rt = (wave < 4) ? wave : 11 - wave, i = 16 * rt + fr;
    const bf16* vhp = ML ? head_ptr(F.ws, C_MV, MDV, MH, b, h) : head_ptr(F.ws, C_RV, RDV, RH, b, h);
    const bf16* ghp = ML ? head_ptr(F.ws, C_MO, MDV, MH, b, h) : head_ptr(F.ws, C_RG, RDV, RH, b, h);
    float mprev = 0.f;
    const float lg = ML ? 0.f : ret_log_gamma(h);
    if (ML) {
        mprev = ((const float*)(F.ws + WS_MP))[u];
        if (wave == 0) { float amax, blast; gate_scan((const float*)(F.ws + WS_GI), (const float*)(F.ws + WS_LF), row0, h, mprev, sA, sB, sG, amax, blast, lane); }
        stage_conv(kreg, head_ptr(F.ws, C_MK, MDK, MH, b, h), F.in[7], F.in[8], c * CH, 1024 + MDK * h, 0.0625f, nullptr, tid);
        stage_conv(qreg, head_ptr(F.ws, C_MQ, MDK, MH, b, h), F.in[7], F.in[8], c * CH, MDK * h, 1.0f, nullptr, tid);
    } else {
        stage_rot(kreg, head_ptr(F.ws, C_RK, RDK, RH, b, h), (const float*)(F.ws + WS_ROT), c * CH, 0.08838834764831845f, 0.f, tid);
        stage_rot(qreg, head_ptr(F.ws, C_RQ, RDK, RH, b, h), (const float*)(F.ws + WS_ROT), c * CH, 1.0f, 0.f, tid);
    }
    __syncthreads();
    bf16x8 qf[KS];
#pragma unroll
    for (int ks = 0; ks < KS; ++ks) qf[ks] = *(const LAS bf16x8*)(qreg + (i * PK + 32 * ks + 8 * g) * 2);
    float rowscale, gi = 0.f, en = 0.f;
    if (ML) { gi = sG[i]; rowscale = __expf(mprev - gi); en = __expf(-(sB[i] + gi)); }
    else rowscale = __expf(lg * (float)(i + 1));
    __syncthreads();
    v4u vpre[4], spre[NSTL];
#define PC_LOAD_SLICE(sl_) do { \
        _Pragma("unroll") for (int it = 0; it < 4; ++it) { const int p_ = tid + 512 * it, j_ = p_ >> 4, ch_ = p_ & 15; vpre[it] = *(const GAS v4u*)(vhp + (size_t)(c * CH + j_) * DV + 128 * (sl_) + 8 * ch_); } \
        _Pragma("unroll") for (int it = 0; it < NSTL; ++it) { const int p_ = tid + 512 * it, r_ = p_ / (DK / 8), ch_ = p_ % (DK / 8); spre[it] = *(const GAS v4u*)(st + (size_t)(128 * (sl_) + r_) * DK + 8 * ch_); } } while (0)
#define PC_WRITE_SLICE() do { \
        _Pragma("unroll") for (int it = 0; it < 4; ++it) { const int p_ = tid + 512 * it, j_ = p_ >> 4, ch_ = p_ & 15; *(LAS v4u*)(vreg + (j_ * PV_PITCH + 8 * ch_) * 2) = vpre[it]; } \
        _Pragma("unroll") for (int it = 0; it < NSTL; ++it) { const int p_ = tid + 512 * it, r_ = p_ / (DK / 8), ch_ = p_ % (DK / 8); *(LAS v4u*)(kreg + (r_ * PK + 8 * ch_) * 2) = spre[it]; } } while (0)
    PC_LOAD_SLICE(0);
    bf16x8 nvp[ML ? KS : 1];
    if (ML) { const bf16* nrow = st + (size_t)MDV * DK;
#pragma unroll
        for (int ks = 0; ks < KS; ++ks) nvp[ks] = *(const GAS bf16x8*)(nrow + 32 * ks + 8 * g); }
    float rowsum = 0.f;
#pragma unroll
    for (int jt = 0; jt < 8; ++jt) {
        v2u o; o.x = 0u; o.y = 0u;
        if (jt <= rt) {
            f32x4 a = (f32x4){0.f, 0.f, 0.f, 0.f};
#pragma unroll
            for (int ks = 0; ks < KS; ++ks) { const bf16x8 kf = *(const LAS bf16x8*)(kreg + ((16 * jt + fr) * PK + 32 * ks + 8 * g) * 2); a = MFMA16(kf, qf[ks], a); }
            float p[4];
            f32x4 aj = (f32x4){0.f, 0.f, 0.f, 0.f}; if (ML) aj = *(const LAS f32x4*)(sA + 16 * jt + 4 * g);
#pragma unroll
            for (int r = 0; r < 4; ++r) { const int j = 16 * jt + 4 * g + r;
                const float w = ML ? __expf(aj[r] - gi) : __expf(lg * (float)(i - j));
                p[r] = (j <= i) ? a[r] * w : 0.f; rowsum += p[r]; }
            o.x = pk2(p[0], p[1]); o.y = pk2(p[2], p[3]);
        }
        *(LAS v2u*)(preg + (fr * PV_PITCH + 16 * jt + 4 * g) * 2) = o;
    }
    float inv = 1.0f;
    if (ML) {
        rowsum += __shfl_xor(rowsum, 16); rowsum += __shfl_xor(rowsum, 32);
        float qn = 0.f;
#pragma unroll
        for (int ks = 0; ks < KS; ++ks) { const bf16x8 nv = nvp[ks];
#pragma unroll
            for (int e = 0; e < 8; ++e) qn += bf2f(qf[ks][e]) * bf2f(nv[e]); }
        qn += __shfl_xor(qn, 16); qn += __shfl_xor(qn, 32);
        const float nq = rowsum + rowscale * qn;
        inv = 1.0f / fmaxf(fabsf(nq), en);
    }
    const int ocol = ML ? 2048 + MDV * h : RDV * h, gcol = ML ? C_MO + MDV * h : C_RG + RDV * h;
    const int orow0 = row0 + 16 * rt;
    const int lr = lane >> 4, lc = lane & 15;
    float sumsq = 0.f;
    v2u opk[NSL][8];
    v4u gpre[4];
#define PC_LOAD_GATE(sl_) do { _Pragma("unroll") for (int k = 0; k < 4; ++k) gpre[k] = *(const GAS v4u*)(ghp + (size_t)(c * CH + 16 * rt + 4 * k + lr) * DV + 128 * (sl_) + 8 * lc); } while (0)
    __syncthreads();
#pragma unroll
    for (int sl = 0; sl < NSL; ++sl) {
        PC_WRITE_SLICE();
        __syncthreads();
        if (sl + 1 < NSL) PC_LOAD_SLICE(sl + 1);
        else PC_LOAD_GATE(0);
        f32x4 acc[8];
#pragma unroll
        for (int vt = 0; vt < 8; ++vt) { f32x4 a = (f32x4){0.f, 0.f, 0.f, 0.f};
#pragma unroll
            for (int ks = 0; ks < KS; ++ks) { const bf16x8 sf = *(const LAS bf16x8*)(kreg + ((16 * vt + fr) * PK + 32 * ks + 8 * g) * 2); a = MFMA16(sf, qf[ks], a); }
            acc[vt] = a * rowscale;
            if (vt & 1) asm volatile("" ::: "memory"); }
#pragma unroll
        for (int k2 = 0; k2 < 4; ++k2) {
            if (2 * k2 <= rt) {
                const bf16x8 pf = *(const LAS bf16x8*)(preg + (fr * PV_PITCH + 32 * k2 + 8 * g) * 2);
#pragma unroll
                for (int vt = 0; vt < 8; ++vt) { const bf16x8 vf = tr_frag(vreg, PV_PITCH, 32 * k2, 16 * vt, lane); acc[vt] = MFMA16(vf, pf, acc[vt]); } } }
#pragma unroll
        for (int vt = 0; vt < 8; ++vt) { const f32x4 a = acc[vt] * inv; sumsq += (a[0] * a[0] + a[1] * a[1]) + (a[2] * a[2] + a[3] * a[3]);
            opk[sl][vt].x = pk2(a[0], a[1]); opk[sl][vt].y = pk2(a[2], a[3]); }
        __syncthreads();
    }
#undef PC_LOAD_SLICE
#undef PC_WRITE_SLICE
    sumsq += __shfl_xor(sumsq, 16); sumsq += __shfl_xor(sumsq, 32);
    if (g == 0) sR[fr] = 1.0f / sqrtf(sumsq * (1.0f / DV) + NORM_EPS);
    const float* hn = F.in[ML ? 12 : 11] + (ML ? MDV : RDV) * h;
#pragma unroll
    for (int sl = 0; sl < NSL; ++sl) {
#pragma unroll
        for (int vt = 0; vt < 8; ++vt) *(LAS v2u*)(oreg + (fr * PV_PITCH + 16 * vt + 4 * g) * 2) = opk[sl][vt];
        v4u gt[4];
#pragma unroll
        for (int k = 0; k < 4; ++k) gt[k] = gpre[k];
        if (sl + 1 < NSL) PC_LOAD_GATE(sl + 1);
        const f32x4 gn0 = *(const GAS f32x4*)(hn + 128 * sl + 8 * lc), gn1 = *(const GAS f32x4*)(hn + 128 * sl + 8 * lc + 4);
#pragma unroll
        for (int k = 0; k < 4; ++k) { const int r = 4 * k + lr;
            const v4u x = *(const LAS v4u*)(oreg + (r * PV_PITCH + 8 * lc) * 2);
            const float rs = sR[r];
            const float xv[8] = {bflo(x.x), bfhi(x.x), bflo(x.y), bfhi(x.y), bflo(x.z), bfhi(x.z), bflo(x.w), bfhi(x.w)};
            const float gv[8] = {bflo(gt[k].x), bfhi(gt[k].x), bflo(gt[k].y), bfhi(gt[k].y), bflo(gt[k].z), bfhi(gt[k].z), bflo(gt[k].w), bfhi(gt[k].w)};
            const float gnv[8] = {gn0[0], gn0[1], gn0[2], gn0[3], gn1[0], gn1[1], gn1[2], gn1[3]};
            float y[8];
#pragma unroll
            for (int e = 0; e < 8; ++e) { const float sg = __builtin_amdgcn_rcpf(1.0f + __expf(-gv[e])); y[e] = xv[e] * rs * gnv[e] * (ML ? sg : gv[e] * sg); }
            v4u o; o.x = pk2(y[0], y[1]); o.y = pk2(y[2], y[3]); o.z = pk2(y[4], y[5]); o.w = pk2(y[6], y[7]);
            *(GAS v4u*)(mixed + blk_off(orow0 + r, ocol + 128 * sl + 8 * lc, D >> 6)) = o; }
        asm volatile("" ::: "memory");
    }
#undef PC_LOAD_GATE
    __syncthreads();
}
struct Args { const float* in[19]; float* out; unsigned char* ws; };
__global__ void __launch_bounds__(NWAVES * 64, 2) hybrid_fwd(Args args) {
    extern __shared__ __attribute__((aligned(16))) unsigned char lds[];
    Frame F;
    F.lds = (LAS unsigned char*)lds;
    F.MISC = (volatile LAS unsigned*)(F.lds + MISC_OFF);
    F.tid = threadIdx.x; F.lane = F.tid & 63; F.wave = __builtin_amdgcn_readfirstlane(F.tid >> 6);
    F.G = gridDim.x; { const int bx = blockIdx.x; F.vcu = (F.G % 8 == 0) ? (bx % 8) * (F.G / 8) + bx / 8 : bx; }
#pragma unroll
    for (int i = 0; i < 19; ++i) F.in[i] = args.in[i];
    F.out = args.out; F.ws = args.ws;
    unsigned char* ws = args.ws;
    F.ctl = (gu32*)(ws + WS_CTL);
    for (int u = F.tid; u < (LDS_BYTES - LDSCTL_OFF) / 4; u += NWAVES * 64) ((LAS unsigned*)(F.lds + LDSCTL_OFF))[u] = 0u;
    __syncthreads();
    XcdBarrier bar = xcd_barrier_post((unsigned*)(F.ctl + CW_BAR), F.MISC + 8);
#define GRID_BAR() do { xcd_barrier(bar); asm volatile("" : "+v"(F.tid)); F.lane = F.tid & 63; } while (0)
    const int gw = F.vcu * NWAVES + F.wave, NGW = F.G * NWAVES;
    bf16* XN = (bf16*)(ws + WS_XN); bf16* BIG = (bf16*)(ws + WS_BIG); bf16* RES = (bf16*)(ws + WS_RES);
    float dummy[8];

#ifndef PMX_IN
#define PMX_IN 8
#endif
#ifndef PMX_RES
#define PMX_RES 2
#endif
#ifndef SPM_DOWN
#define SPM_DOWN 8
#endif
#ifndef PMX_P2
#define PMX_P2 PMX_RES
#endif
#ifndef PMX_P8
#define PMX_P8 4
#endif
#ifndef PMX_P11
#define PMX_P11 PMX_RES
#endif
#ifndef PHASE_MASK
#define PHASE_MASK 0xFFFF
#endif
#define PH(n) if constexpr ((PHASE_MASK >> (n)) & 1)
    PH(0) {
        LAS float* scr = (LAS float*)(F.lds + RING_OFF + F.wave * 16384);
        constexpr int I_GU = (D / 64) * (FF / 32), I_DN = (FF / 64) * (D / 32), I_IN = (D / 64) * (NPROJ / 32), I_OUT = (D / 64) * (D / 32);
        constexpr int NLATE = 2 * I_DN + I_OUT;
        for (int it = gw; it < NLATE; it += NGW) {
            int r = it;
            if (r < I_DN) { transpose_plain(F.in[4], FF, D, D, (bf16*)(ws + WS_WD1), scr, r, F.lane); continue; } r -= I_DN;
            if (r < I_OUT) { transpose_plain(F.in[13], D, D, D, (bf16*)(ws + WS_WOUT), scr, r, F.lane); continue; } r -= I_OUT;
            transpose_plain8(F.in[17], FF, D, D, ws + WS_WD2, scr, r, F.lane, pg8::F8_W_SCALE);
        }
        const size_t gt = (size_t)F.vcu * 512 + F.tid, NT = (size_t)F.G * 512;
        for (size_t e = gt; e < (size_t)SEQ * 64; e += NT) {
            const int pos = (int)(e >> 6), j = (int)(e & 63);
            double rev = (double)pos * INV_FREQ[j] * 0.15915494309189535; rev -= __builtin_floor(rev);
            const float rf = (float)rev;
            f32x2 cs; cs.x = __builtin_amdgcn_cosf(rf); cs.y = __builtin_amdgcn_sinf(rf);
            ((GAS f32x2*)(ws + WS_ROT))[e] = cs;
        }
        for (size_t e = gt; e < (size_t)8 * D; e += NT) { const int hh = (int)(e >> 12), k = (int)(e & 4095); ((float*)(ws + WS_WG8))[e] = F.in[6][(size_t)k * NPROJ_ALL + NPROJ + hh]; }
        for (int m = gw; m < M; m += NGW) norm_row<0>(F.in[0] + (size_t)m * D, F.in[1], XN, m, nullptr, nullptr, dummy, F.lane);
        for (int it = gw; it < 2 * I_GU; it += NGW) {
            if (it < I_GU) transpose_gu(F.in[2], 0, (bf16*)(ws + WS_WGU1), scr, it, F.lane); else transpose_gu(F.in[3], 1, (bf16*)(ws + WS_WGU1), scr, it - I_GU, F.lane); }
    }
    GRID_BAR();
    PH(1) { pg8::Gemm g{XN, (const bf16*)(ws + WS_WGU1), M, 2 * FF, D}; pg8::StaticOrder S; S.init(M, 2 * FF, F.G, (int)blockIdx.x);
      pg8::EpiSwiGLU E{BIG, FF};
      pg8::gemm_phase<pg8::EpiSwiGLU, pg8::StaticOrder, PG8_ALIGN, PG8_SP2>(F.lds + RING_OFF, g, S, E); }
    GRID_BAR();
    PH(2) { pg8::Gemm g{BIG, (const bf16*)(ws + WS_WD1), M, D, FF}; pg8::Sweep2DOrder<M / 256, SPM_DOWN> S; S.init(M, D, F.G, (int)blockIdx.x);
      pg8::EpiResBf16<true> E{F.in[0], RES, D, 0.5f};
      pg8::gemm_phase<pg8::EpiResBf16<true>, pg8::Sweep2DOrder<M / 256, SPM_DOWN>, PG8_ALIGN, PG8_SP2>(F.lds + RING_OFF, g, S, E); }
    GRID_BAR();
    PH(3) {
        LAS float* wg = (LAS float*)(F.lds + RING_OFF);
        for (int e = F.tid; e < 8 * D / 4; e += NWAVES * 64) ((LAS f32x4*)wg)[e] = ((const GAS f32x4*)(ws + WS_WG8))[e];
        __syncthreads();
        float* GI = (float*)(ws + WS_GI); float* LFp = (float*)(ws + WS_LF);
        for (int m = gw; m < M; m += NGW) {
            float gd[8];
            norm_row_bf<1>(RES + (size_t)m * D, F.in[5], XN, m, nullptr, wg, gd, F.lane);
#pragma unroll
            for (int hh = 0; hh < 8; ++hh) gd[hh] = wave_sum(gd[hh]);
            if (F.lane == 0) {
#pragma unroll
                for (int hh = 0; hh < 4; ++hh) { GI[(size_t)m * 4 + hh] = gd[hh] + F.in[9][hh]; LFp[(size_t)m * 4 + hh] = log_sigmoid(gd[4 + hh] + F.in[10][hh]); }
            }
        }
        __syncthreads();
        {
            LAS float* scr = (LAS float*)(F.lds + RING_OFF + F.wave * 16384);
            constexpr int I_IN = (D / 64) * (NPROJ / 32);
            for (int it = gw; it < I_IN; it += NGW) transpose_plain(F.in[6], D, NPROJ, NPROJ_ALL, (bf16*)(ws + WS_WIN), scr, it, F.lane);
        }
    }
    GRID_BAR();
    PH(4) { pg8::Gemm g{XN, (const bf16*)(ws + WS_WIN), M, NPROJ, D}; pg8::SweepOrder<PMX_IN, M / 256, NPROJ / 256> S; S.init(M, NPROJ, F.G, (int)blockIdx.x);
      pg8::EpiProj E{BIG, M, SEQ};
      pg8::gemm_phase<pg8::EpiProj, pg8::SweepOrder<PMX_IN, M / 256, NPROJ / 256>, PG8_ALIGN, PG8_SP2>(F.lds + RING_OFF, g, S, E); }
    GRID_BAR();
    PH(5) { for (int u = F.vcu; u < BATCH * RH * NCH; u += F.G) phaseA_unit<false>(F, u); }
    PH(13) { for (int u = F.vcu; u < BATCH * MH * NCH; u += F.G) phaseA_unit<true>(F, u); }
    GRID_BAR();
    PH(6) { phaseB(F); }
    GRID_BAR();
    PH(7) { for (int u = F.vcu; u < BATCH * RH * NCH; u += F.G) phaseC_unit<false>(F, u); }
    PH(14) { for (int u = F.vcu; u < BATCH * MH * NCH; u += F.G) phaseC_unit<true>(F, u); }
    GRID_BAR();
    PH(8) { pg8::Gemm g{XN, (const bf16*)(ws + WS_WOUT), M, D, D}; pg8::SweepOrder<PMX_P8, M / 256, D / 256> S; S.init(M, D, F.G, (int)blockIdx.x);
      pg8::EpiResBf16<false> E{RES, RES, D, 1.0f};
      pg8::gemm_phase<pg8::EpiResBf16<false>, pg8::SweepOrder<PMX_P8, M / 256, D / 256>, PG8_ALIGN, PG8_SP2>(F.lds + RING_OFF, g, S, E); }
    GRID_BAR();
    PH(9) {
        for (int m = gw; m < M; m += NGW) norm_row_bf<0, true>(RES + (size_t)m * D, F.in[14], XN, m, nullptr, nullptr, dummy, F.lane, ws + WS_XN8);
        LAS float* scr = (LAS float*)(F.lds + RING_OFF + F.wave * 16384);
        constexpr int I_GU = (D / 64) * (FF / 32);
        for (int it = gw; it < 2 * I_GU; it += NGW) {
            const int half = it >= I_GU, r = it - half * I_GU, kb = r / (FF / 32), n0 = 32 * (r % (FF / 32));
            if (n0 < GU8 * 128) transpose_gu8(F.in[15 + half], half, ws + WS_WGU2, scr, kb, n0, F.lane, pg8::F8_W_SCALE);
            else transpose_gu(F.in[15 + half], half, (bf16*)(ws + WS_WGU2), scr, r, F.lane); }
    }
    GRID_BAR();
    PH(10) {
      { pg8::Gemm g{(const bf16*)(ws + WS_XN8), (const bf16*)(ws + WS_WGU2), M, GU8 * 256, D / 2};     pg8::StaticOrder S; S.init(M, GU8 * 256, F.G, (int)blockIdx.x);
        pg8::EpiSwiGLU8T<true> E{(unsigned char*)BIG, FF, 0, 1.0f / (pg8::F8_X_SCALE * pg8::F8_W_SCALE)};
        pg8::gemm_phase<pg8::EpiSwiGLU8T<true>, pg8::StaticOrder, PG8_ALIGN, PG8_SP2, true>(F.lds + RING_OFF, g, S, E); }
      { pg8::Gemm g{XN, (const bf16*)(ws + WS_WGU2) + (size_t)GU8 * 256 * D, M, 2 * FF - GU8 * 256, D}; pg8::StaticOrder S; S.init(M, 2 * FF - GU8 * 256, F.G, (int)blockIdx.x);
        pg8::EpiSwiGLU8T<false> E{(unsigned char*)BIG, FF, GU8, 1.0f};
        pg8::gemm_phase<pg8::EpiSwiGLU8T<false>, pg8::StaticOrder, PG8_ALIGN, PG8_SP2>(F.lds + RING_OFF, g, S, E); } }
    GRID_BAR();
    PH(11) { pg8::Gemm g{BIG, (const bf16*)(ws + WS_WD2), M, D, FF / 2};     pg8::Sweep2DOrder<M / 256, SPM_DOWN> S; S.init(M, D, F.G, (int)blockIdx.x);
      pg8::EpiResBf16<false> E{RES, RES, D, 0.5f / (pg8::F8_HID_SCALE * pg8::F8_W_SCALE)};
      pg8::gemm_phase<pg8::EpiResBf16<false>, pg8::Sweep2DOrder<M / 256, SPM_DOWN>, PG8_ALIGN, PG8_SP2, true>(F.lds + RING_OFF, g, S, E); }
    GRID_BAR();
    PH(12) for (int m = gw; m < M; m += NGW) norm_row_bf<2>(RES + (size_t)m * D, F.in[18], nullptr, 0, F.out + (size_t)m * D, nullptr, dummy, F.lane);
}

extern "C" void kernel_launch(void* const* d_in, const int* in_sizes, int n_in, void* d_out, int out_size, void* d_ws, size_t ws_size, hipStream_t stream) {
    static int grid = 0;
    if (grid == 0) {
        if (n_in != 19 || in_sizes[0] != M * D || out_size != M * D || ws_size < WS_END) { fprintf(stderr, "kernel_launch: unexpected problem: n_in %d in0 %d out %d ws %zu (need %zu); nothing launched\n", n_in, n_in > 0 ? in_sizes[0] : -1, out_size, ws_size, (size_t)WS_END); grid = -1; return; }
        int dev = 0, cus = 0, per_cu = 0;
        if (hipGetDevice(&dev) != hipSuccess || hipDeviceGetAttribute(&cus, hipDeviceAttributeMultiprocessorCount, dev) != hipSuccess) { fprintf(stderr, "kernel_launch: device query failed\n"); grid = -1; return; }
        if (hipFuncSetAttribute((const void*)hybrid_fwd, hipFuncAttributeMaxDynamicSharedMemorySize, LDS_BYTES) != hipSuccess) { fprintf(stderr, "kernel_launch: hipFuncSetAttribute failed\n"); grid = -1; return; }
        if (hipOccupancyMaxActiveBlocksPerMultiprocessor(&per_cu, (const void*)hybrid_fwd, NWAVES * 64, LDS_BYTES) != hipSuccess || per_cu < 1) fprintf(stderr, "kernel_launch: occupancy query reports %d workgroups per CU\n", per_cu);
        (void)hipGetLastError();
        grid = cus;
    }
    if (grid < 0) return;
    if (hipMemsetAsync((char*)d_ws + WS_CTL, 0, CTL_ZERO_BYTES, stream) != hipSuccess) { fprintf(stderr, "kernel_launch: memset failed\n"); return; }
    Args a{};
    for (int i = 0; i < 19; ++i) a.in[i] = (const float*)d_in[i];
    a.out = (float*)d_out; a.ws = (unsigned char*)d_ws;
    hipLaunchKernelGGL(hybrid_fwd, dim3(grid), dim3(NWAVES * 64), LDS_BYTES, stream, a);
    const hipError_t le = hipPeekAtLastError();
    if (le != hipSuccess) fprintf(stderr, "kernel_launch: launch failed: %s\n", hipGetErrorName(le));
}
```

```cpp
#include <hip/hip_runtime.h>
#include <cstdio>
#include <cstdint>
namespace pg8 {
#define PG8_LAS __attribute__((address_space(3)))
typedef unsigned short bf16_t;
typedef short bf16x8 __attribute__((ext_vector_type(8)));
typedef float f32x4 __attribute__((ext_vector_type(4)));
typedef unsigned u32x4 __attribute__((ext_vector_type(4)));
typedef int i32x4 __attribute__((ext_vector_type(4)));
typedef int i32x8 __attribute__((ext_vector_type(8)));
typedef unsigned u32x2 __attribute__((ext_vector_type(2)));
constexpr int BM = 256, BK = 64, HALF = 128, HTB = HALF * BK * 2  , STAGE_BYTES = 8 * HTB, NXCD = 8, WGM = 8;

__host__ __device__ __forceinline__ int lds_byte(int r, int c) { const int st = (r >> 4) * 2 + (c >> 5), rr = r & 15, cc = c & 31, ob = rr * 64 + cc * 2; return st * 1024 + (ob ^ (((ob >> 9) & 1) << 5)); }
__host__ __device__ __forceinline__ void stage_rc(int b, int& R, int& C) { const int st = b / 1024, sb = b % 1024, swz = sb ^ (((sb >> 9) & 1) << 5); R = (st >> 1) * 16 + swz / 64; C = (st & 1) * 32 + (swz % 64) / 2; }
__host__ __device__ __forceinline__ int perm32(int rho) { const int n = rho >> 4, i = rho & 15; return 8 * (i >> 2) + 4 * n + (i & 3); }

struct Unit { int pm, pn; };
struct Gemm { const bf16_t* A; const bf16_t* Bt; int M, N, K; };

struct StaticOrder {
    int nM, nN, nwg, G, c;
    __host__ __device__ void init(int M, int N, int G_, int c_) { nM = M / BM; nN = N / BM; nwg = nM * nN; G = G_; c = c_; }
    __host__ __device__ bool next(int i, Unit& u) const {
        const long L = (long)i * G + c; if (L >= nwg) return false;
        int wgid = (int)L; { const int q = nwg / NXCD, r = nwg % NXCD, xcd = wgid % NXCD, off = wgid / NXCD; wgid = (xcd < r ? xcd * (q + 1) : r * (q + 1) + (xcd - r) * q) + off; }
        const int nig = WGM * nN, gid = wgid / nig, fm = gid * WGM, gsz = (nM - fm) < WGM ? (nM - fm) : WGM;
        u.pm = fm + ((wgid % nig) % gsz); u.pn = (wgid % nig) / gsz; return true;
    }
    __device__ __forceinline__ void a_ready(const Unit&) const {}
    __device__ __forceinline__ void done(const Unit&) const {}
};


template <int PMX, int NM, int NN> struct SweepOrder {
    int c;
    __host__ __device__ void init(int, int, int, int c_) { c = c_; }
    __host__ __device__ bool next(int i, Unit& u) const {
        constexpr int PNR = 32 / PMX;
        constexpr int nblk = NN / PNR; const int sweep = i / nblk, pnb = i % nblk, x = c & 7, j = c >> 3;
        if (sweep * 8 * PMX >= NM) return false;
        u.pm = sweep * 8 * PMX + x * PMX + (j % PMX); u.pn = pnb * PNR + j / PMX; return true;
    }
    __device__ __forceinline__ void a_ready(const Unit&) const {}
    __device__ __forceinline__ void done(const Unit&) const {}
};

template <int NM, int SPM = 4> struct Sweep2DOrder {
    static constexpr bool SPLITK = false;
    int c;
    __host__ __device__ void init(int, int, int, int c_) { c = c_; }
    __host__ __device__ bool next(int i, Unit& u) const {
        constexpr int PNR = 32 / SPM, XB = 16 / PNR;
        if (i * 16 >= NM) return false;
        const int x = c & 7, j = c >> 3;
        u.pm = i * 16 + (x / XB) * SPM + (j % SPM); u.pn = (x % XB) * PNR + (j / SPM); return true;
    }
    __device__ __forceinline__ void a_ready(const Unit&) const {}
    __device__ __forceinline__ void done(const Unit&) const {}
};

__device__ __forceinline__ unsigned cvt_pk_bf16(float lo, float hi) { unsigned r; asm volatile("v_cvt_pk_bf16_f32 %0, %1, %2" : "=v"(r) : "v"(lo), "v"(hi)); return r; }

__host__ __device__ __forceinline__ void proj_seg(int col, int& seg_start, int& hw, int& H) {
    if (col < 2048) { hw = 128; H = 8; seg_start = col & ~1023; }
    else if (col < 6144) { hw = 256; H = 8; seg_start = 2048 + ((col - 2048) & ~2047); }
    else if (col < 8192) { hw = 256; H = 4; seg_start = 6144 + ((col - 6144) & ~1023); }
    else { hw = 512; H = 4; seg_start = 8192 + ((col - 8192) & ~2047); }
}
struct EpiProj {
    static constexpr bool PERM = true, AFTER_DRAIN = false;
    bf16_t* O; int Mrows, SEQL;
    __device__ __forceinline__ void operator()(const f32x4 (&acc)[2][2][4][2], const Unit& u, int wr, int wc, int fr, int fq) const {
        const int row0 = u.pm * BM + wr * 64 + fr;
        size_t cbase[2]; int hwv[2];
#pragma unroll
        for (int bj = 0; bj < 2; ++bj) { const int cb = u.pn * BM + bj * HALF; int ss, hw, H; proj_seg(cb, ss, hw, H);
            const int cs = cb - ss, h = cs / hw, d0 = cs % hw;
            hwv[bj] = hw; cbase[bj] = (size_t)ss * Mrows + (size_t)h * SEQL * hw + d0 + wc * 32 + 8 * fq + (size_t)0;
            cbase[bj] += 0; (void)H; hwv[bj] = hw | (H << 16); }
#pragma unroll
        for (int ai = 0; ai < 2; ++ai)
#pragma unroll
            for (int m = 0; m < 4; ++m) { const int row = row0 + ai * HALF + m * 16, b = row / SEQL, s = row % SEQL;
#pragma unroll
                for (int bj = 0; bj < 2; ++bj) { const int hw = hwv[bj] & 0xffff, H = hwv[bj] >> 16; const f32x4 v0 = acc[ai][bj][m][0], v1 = acc[ai][bj][m][1];
                    u32x4 w; w.x = cvt_pk_bf16(v0[0], v0[1]); w.y = cvt_pk_bf16(v0[2], v0[3]); w.z = cvt_pk_bf16(v1[0], v1[1]); w.w = cvt_pk_bf16(v1[2], v1[3]);
                    *(u32x4*)(O + cbase[bj] + ((size_t)b * H * SEQL + s) * hw) = w; } }
    }
};
__device__ __forceinline__ float silu_mul(float g, float u) { return g * u * __builtin_amdgcn_rcpf(1.0f + __builtin_amdgcn_exp2f(-1.44269504089f * g)); }
struct EpiSwiGLU {
    static constexpr bool PERM = true, AFTER_DRAIN = false;
    bf16_t* O; int ldc;
    __device__ __forceinline__ void operator()(const f32x4 (&acc)[2][2][4][2], const Unit& u, int wr, int wc, int fr, int fq) const {
        const int row0 = u.pm * BM + wr * 64 + fr, col0 = u.pn * HALF + wc * 32 + 8 * fq;
#pragma unroll
        for (int ai = 0; ai < 2; ++ai)
#pragma unroll
            for (int m = 0; m < 4; ++m) { const int row = row0 + ai * HALF + m * 16; bf16_t* rowp = O + ((size_t)((row >> 8) * (ldc >> 6) + (col0 >> 6)) * 256 + (row & 255)) * 64 + (col0 & 63);
                const f32x4 g0 = acc[ai][0][m][0], g1 = acc[ai][0][m][1], u0 = acc[ai][1][m][0], u1 = acc[ai][1][m][1];
                u32x4 w; w.x = cvt_pk_bf16(silu_mul(g0[0], u0[0]), silu_mul(g0[1], u0[1])); w.y = cvt_pk_bf16(silu_mul(g0[2], u0[2]), silu_mul(g0[3], u0[3]));
                w.z = cvt_pk_bf16(silu_mul(g1[0], u1[0]), silu_mul(g1[1], u1[1])); w.w = cvt_pk_bf16(silu_mul(g1[2], u1[2]), silu_mul(g1[3], u1[3]));
                *(u32x4*)rowp = w; }
    }
};
template <bool BASE_F32> struct EpiResBf16 {
    static constexpr bool PERM = true, AFTER_DRAIN = false;
    const void* base; bf16_t* O; int ldc; float alpha;
    __device__ __forceinline__ void operator()(const f32x4 (&acc)[2][2][4][2], const Unit& u, int wr, int wc, int fr, int fq) const {
        const int row0 = u.pm * BM + wr * 64 + fr, col0 = u.pn * BM + wc * 32 + 8 * fq;
#pragma unroll
        for (int ai = 0; ai < 2; ++ai)
#pragma unroll
            for (int m = 0; m < 4; ++m) { const size_t off = (size_t)(row0 + ai * HALF + m * 16) * ldc + col0;
#pragma unroll
                for (int bj = 0; bj < 2; ++bj) { const size_t o = off + bj * HALF; f32x4 b0, b1;
                    if (BASE_F32) { b0 = *(const f32x4*)((const float*)base + o); b1 = *(const f32x4*)((const float*)base + o + 4); }
                    else { const u32x4 bw = *(const u32x4*)((const bf16_t*)base + o);
                        b0 = (f32x4){__builtin_bit_cast(float, bw.x << 16), __builtin_bit_cast(float, bw.x & 0xffff0000u), __builtin_bit_cast(float, bw.y << 16), __builtin_bit_cast(float, bw.y & 0xffff0000u)};
                        b1 = (f32x4){__builtin_bit_cast(float, bw.z << 16), __builtin_bit_cast(float, bw.z & 0xffff0000u), __builtin_bit_cast(float, bw.w << 16), __builtin_bit_cast(float, bw.w & 0xffff0000u)}; }
                    const f32x4 r0 = b0 + alpha * acc[ai][bj][m][0], r1 = b1 + alpha * acc[ai][bj][m][1];
                    u32x4 w; w.x = cvt_pk_bf16(r0[0], r0[1]); w.y = cvt_pk_bf16(r0[2], r0[3]); w.z = cvt_pk_bf16(r1[0], r1[1]); w.w = cvt_pk_bf16(r1[2], r1[3]);
                    *(u32x4*)(O + o) = w; }
                if (m & 1) asm volatile("" ::: "memory"); }
    }
};
template <bool P> struct EpiNull {
    static constexpr bool PERM = P, AFTER_DRAIN = false;
    __device__ __forceinline__ void operator()(const f32x4 (&acc)[2][2][4][2], const Unit& u, int wr, int wc, int fr, int fq) const {
#pragma unroll
        for (int ai = 0; ai < 2; ++ai)
#pragma unroll
            for (int bj = 0; bj < 2; ++bj)
#pragma unroll
                for (int m = 0; m < 4; ++m)
#pragma unroll
                    for (int n = 0; n < 2; ++n) asm volatile("" :: "v"(acc[ai][bj][m][n]));
    }
};
__host__ __device__ __forceinline__ size_t blk8_off(int r, int k, int nkt8) { return ((size_t)((r >> 8) * nkt8 + (k >> 7)) * 256 + (r & 255)) * 128 + (k & 127); }
__device__ __forceinline__ float sat_e4m3(float v) { return __builtin_amdgcn_fmed3f(v, -448.0f, 448.0f); }
__device__ __forceinline__ unsigned pack4_fp8(float a, float b, float c, float d) { int w = __builtin_amdgcn_cvt_pk_fp8_f32(sat_e4m3(a), sat_e4m3(b), 0, false); w = __builtin_amdgcn_cvt_pk_fp8_f32(sat_e4m3(c), sat_e4m3(d), w, true); return (unsigned)w; }
constexpr float F8_HID_SCALE = 16.0f, F8_W_SCALE = 2048.0f, F8_X_SCALE = 16.0f;
template <bool SCALED> struct EpiSwiGLU8T {
    static constexpr bool PERM = true, AFTER_DRAIN = false;
    unsigned char* O; int ldc; int pn0; float pre;
    __device__ __forceinline__ float hm(float g, float u) const { return SCALED ? F8_HID_SCALE * silu_mul(pre * g, pre * u) : F8_HID_SCALE * silu_mul(g, u); }
    __device__ __forceinline__ void operator()(const f32x4 (&acc)[2][2][4][2], const Unit& u, int wr, int wc, int fr, int fq) const {
        const int row0 = u.pm * BM + wr * 64 + fr, col0 = (u.pn + pn0) * HALF + wc * 32 + 8 * fq;
#pragma unroll
        for (int ai = 0; ai < 2; ++ai)
#pragma unroll
            for (int m = 0; m < 4; ++m) { const int row = row0 + ai * HALF + m * 16;
                const f32x4 g0 = acc[ai][0][m][0], g1 = acc[ai][0][m][1], u0 = acc[ai][1][m][0], u1 = acc[ai][1][m][1];
                u32x2 w;
                w.x = pack4_fp8(hm(g0[0], u0[0]), hm(g0[1], u0[1]), hm(g0[2], u0[2]), hm(g0[3], u0[3]));
                w.y = pack4_fp8(hm(g1[0], u1[0]), hm(g1[1], u1[1]), hm(g1[2], u1[2]), hm(g1[3], u1[3]));
                *(u32x2*)(O + blk8_off(row, col0, ldc >> 7)) = w; }
    }
};
struct EpiResF32 {
    static constexpr bool PERM = false, AFTER_DRAIN = false;
    const float* base; float* out; int ldc; float alpha;
    __device__ __forceinline__ void operator()(const f32x4 (&acc)[2][2][4][2], const Unit& u, int wr, int wc, int fr, int fq) const {
        const int row0 = u.pm * BM + wr * 64 + fr, col0 = u.pn * BM + wc * 32 + 4 * fq;
#pragma unroll
        for (int ai = 0; ai < 2; ++ai)
#pragma unroll
            for (int m = 0; m < 4; ++m) { const size_t off = (size_t)(row0 + ai * HALF + m * 16) * ldc + col0;
#pragma unroll
                for (int bj = 0; bj < 2; ++bj)
#pragma unroll
                    for (int n = 0; n < 2; ++n) { const f32x4 bs = *(const f32x4*)(base + off + bj * HALF + n * 16); *(f32x4*)(out + off + bj * HALF + n * 16) = bs + alpha * acc[ai][bj][m][n]; }
                asm volatile("" ::: "memory"); }
    }
};

template <class Epi, class Sched, bool ALIGN_EPI = false, bool SP2 = false, bool F8 = false, bool RB = false>
__device__ __forceinline__ void gemm_phase(PG8_LAS unsigned char* lds, const Gemm g, const Sched& S, const Epi& E) {
    int tid_ = threadIdx.x; asm volatile("" : "+v"(tid_));
    const int tid = tid_, wid = __builtin_amdgcn_readfirstlane(tid >> 6), lane = tid & 63, wr = wid >> 2, wc = wid & 3, fr = lane & 15, fq = lane >> 4;
    const int K = g.K, nt = K / BK;
    unsigned voffA[2], voffB[2];
#pragma unroll
    for (int i = 0; i < 2; ++i) { int R, C; stage_rc(tid * 16 + i * 8192, R, C); const int Rb = Epi::PERM ? ((R & ~31) + perm32(R & 31)) : R;
        voffA[i] = (unsigned)(R * BK + C) * 2u; voffB[i] = (unsigned)(Rb * BK + C) * 2u; }
    const size_t kstep = (size_t)(BM * BK * 2);
    const size_t hstep = (size_t)HALF * BK * 2;
    const size_t tstep = (size_t)nt * kstep;
    const unsigned ldsw = (unsigned)wid * 1024u;
    const int fcol = F8 ? 32 * (fq >> 1) + 16 * (fq & 1) : fq * 8;
    const int aoff = lds_byte(wr * 64 + fr, fcol), boff = lds_byte(wc * 32 + fr, fcol);
#define PG8_SA(b, h) (((b) * 2 + (h)) * HTB)
#define PG8_SB(b, h) ((4 + (b) * 2 + (h)) * HTB)
#define PG8_STAGE(bufoff, gbase, voff) do { _Pragma("unroll") for (int _i = 0; _i < 2; ++_i) \
        __builtin_amdgcn_global_load_lds((const unsigned*)((const char*)(gbase) + (voff)[_i]), (PG8_LAS unsigned*)(lds + (bufoff) + ldsw + _i * 8192), 16, 0, 0); } while (0)
#define PG8_LD32(p_) __builtin_shufflevector(*(const PG8_LAS i32x4*)(p_), *(const PG8_LAS i32x4*)((p_) + 16), 0, 1, 2, 3, 4, 5, 6, 7)
#define PG8_LDA(dst, b, h) do { if constexpr (F8) { _Pragma("unroll") for (int m = 0; m < 4; ++m) dst##8[m] = PG8_LD32(lds + PG8_SA(b, h) + aoff + m * 2048); } \
        else { _Pragma("unroll") for (int m = 0; m < 4; ++m) _Pragma("unroll") for (int k = 0; k < 2; ++k) dst[m][k] = *(const PG8_LAS bf16x8*)(lds + PG8_SA(b, h) + aoff + m * 2048 + k * 1024); } } while (0)
#define PG8_LDB(dst, b, h) do { if constexpr (F8) { _Pragma("unroll") for (int n = 0; n < 2; ++n) dst##8[n] = PG8_LD32(lds + PG8_SB(b, h) + boff + n * 2048); } \
        else { _Pragma("unroll") for (int n = 0; n < 2; ++n) _Pragma("unroll") for (int k = 0; k < 2; ++k) dst[n][k] = *(const PG8_LAS bf16x8*)(lds + PG8_SB(b, h) + boff + n * 2048 + k * 1024); } } while (0)
#define PG8_MMA(ai, bj, At, Bt) do { __builtin_amdgcn_s_setprio(1); \
        if constexpr (F8) { _Pragma("unroll") for (int m = 0; m < 4; ++m) _Pragma("unroll") for (int n = 0; n < 2; ++n) \
            asm volatile("v_mfma_scale_f32_16x16x128_f8f6f4 %0, %1, %2, %0, %3, %3 op_sel_hi:[0,0,0]" : "+v"(acc[ai][bj][m][n]) : "v"(Bt##8[n]), "v"(At##8[m]), "v"(sc8)); } \
        else { _Pragma("unroll") for (int m = 0; m < 4; ++m) _Pragma("unroll") for (int n = 0; n < 2; ++n) _Pragma("unroll") for (int k = 0; k < 2; ++k) \
            acc[ai][bj][m][n] = __builtin_amdgcn_mfma_f32_16x16x32_bf16(Bt[n][k], At[m][k], acc[ai][bj][m][n], 0, 0, 0); } \
        __builtin_amdgcn_s_setprio(0); } while (0)
#define PG8_MMA0(ai, bj, At, Bt) do { __builtin_amdgcn_s_setprio(1); \
        if constexpr (F8) { _Pragma("unroll") for (int m = 0; m < 4; ++m) _Pragma("unroll") for (int n = 0; n < 2; ++n) \
            asm volatile("v_mfma_scale_f32_16x16x128_f8f6f4 %0, %1, %2, 0, %3, %3 op_sel_hi:[0,0,0]" : "=v"(acc[ai][bj][m][n]) : "v"(Bt##8[n]), "v"(At##8[m]), "v"(sc8)); } \
        else { _Pragma("unroll") for (int m = 0; m < 4; ++m) _Pragma("unroll") for (int n = 0; n < 2; ++n) { \
            acc[ai][bj][m][n] = __builtin_amdgcn_mfma_f32_16x16x32_bf16(Bt[n][0], At[m][0], (f32x4){0.f, 0.f, 0.f, 0.f}, 0, 0, 0); \
            acc[ai][bj][m][n] = __builtin_amdgcn_mfma_f32_16x16x32_bf16(Bt[n][1], At[m][1], acc[ai][bj][m][n], 0, 0, 0); } } \
        __builtin_amdgcn_s_setprio(0); } while (0)
#define PG8_WAIT_V(n) asm volatile("s_waitcnt vmcnt(" #n ")" ::: "memory")
#define PG8_WAIT_L(n) asm volatile("s_waitcnt lgkmcnt(" #n ")" ::: "memory")
#define PG8_BAR __builtin_amdgcn_s_barrier()
#define PG8_SCHED __builtin_amdgcn_sched_barrier(0)
    Unit cur, nxt; int ui = 0;
    if (!S.next(0, cur)) return;
    f32x4 acc[2][2][4][2];
    bf16x8 At[4][2], B0[2][2], B1[2][2], B0a[2][2], B0b[2][2];
    i32x8 At8[4], B08[2], B18[2], B0a8[2], B0b8[2];
    const int sc8 = 0x7F7F7F7F;
    const char* cA = (const char*)g.A + (size_t)cur.pm * tstep; const char* cB = (const char*)g.Bt + (size_t)cur.pn * tstep;
    S.a_ready(cur);
    if constexpr (SP2) {
        PG8_STAGE(PG8_SB(0, 0), cB, voffB); PG8_STAGE(PG8_SB(0, 1), cB + hstep, voffB); PG8_STAGE(PG8_SA(0, 0), cA, voffA); PG8_STAGE(PG8_SA(0, 1), cA + hstep, voffA);
        if (wr == 1) PG8_BAR;
        PG8_WAIT_V(2); PG8_BAR;
        PG8_STAGE(PG8_SB(1, 0), cB + kstep, voffB); PG8_STAGE(PG8_SA(1, 0), cA + kstep, voffA); PG8_STAGE(PG8_SB(1, 1), cB + hstep + kstep, voffB);
        PG8_WAIT_V(6); PG8_BAR;
    } else {
        PG8_STAGE(PG8_SB(0, 0), cB, voffB); PG8_STAGE(PG8_SA(0, 0), cA, voffA); PG8_STAGE(PG8_SB(0, 1), cB + hstep, voffB); PG8_STAGE(PG8_SA(0, 1), cA + hstep, voffA);
        if (wr == 1) PG8_BAR;
        PG8_WAIT_V(4); PG8_BAR;
        PG8_STAGE(PG8_SB(1, 0), cB + kstep, voffB); PG8_STAGE(PG8_SA(1, 0), cA + kstep, voffA); PG8_STAGE(PG8_SB(1, 1), cB + hstep + kstep, voffB);
        PG8_WAIT_V(6); PG8_BAR;
    }
    for (;;) {
        const bool has_next = S.next(ui + 1, nxt);
        const char* nA = has_next ? (const char*)g.A + (size_t)nxt.pm * tstep : cA; const char* nB = has_next ? (const char*)g.Bt + (size_t)nxt.pn * tstep : cB;
        static_assert(SP2, "the four-phase loop was removed: SP2 only");
        if constexpr (RB) {
#define PG8_KPAIR(MMAX, RD_FIRST, RD_AHEAD) do { \
            RD_FIRST; PG8_LDB(B1, 0, 1); PG8_SCHED; PG8_LDA(At, 0, 0); PG8_STAGE(PG8_SA(1, 1), a1 + hstep, voffA); \
            PG8_WAIT_V(6); PG8_WAIT_L(0); PG8_BAR; MMAX(0, 0, At, B0a); MMAX(0, 1, At, B1); PG8_BAR; PG8_SCHED; \
            PG8_LDA(At, 0, 1); PG8_LDB(B0b, 1, 0); PG8_STAGE(PG8_SB(0, 0), b2, voffB); PG8_STAGE(PG8_SB(0, 1), b2 + hstep, voffB); PG8_STAGE(PG8_SA(0, 0), a2, voffA); \
            PG8_WAIT_V(8); PG8_WAIT_L(0); PG8_BAR; MMAX(1, 0, At, B0a); MMAX(1, 1, At, B1); PG8_BAR; PG8_SCHED; \
            PG8_LDB(B1, 1, 1); PG8_SCHED; PG8_LDA(At, 1, 0); PG8_STAGE(PG8_SA(0, 1), a2 + hstep, voffA); \
            PG8_WAIT_V(6); PG8_WAIT_L(0); PG8_BAR; PG8_MMA(0, 0, At, B0b); PG8_MMA(0, 1, At, B1); PG8_BAR; PG8_SCHED; \
            PG8_LDA(At, 1, 1); RD_AHEAD; PG8_STAGE(PG8_SB(1, 0), b3, voffB); PG8_STAGE(PG8_SB(1, 1), b3 + hstep, voffB); PG8_STAGE(PG8_SA(1, 0), a3, voffA); \
            PG8_WAIT_V(8); PG8_WAIT_L(0); PG8_BAR; PG8_MMA(1, 0, At, B0b); PG8_MMA(1, 1, At, B1); PG8_BAR; PG8_SCHED; } while (0)
#define PG8_NOTHING do { } while (0)
        {
            const char* a1 = cA + kstep; const char* a2 = cA + 2 * kstep; const char* b2 = cB + 2 * kstep; const char* a3 = a2 + kstep; const char* b3 = b2 + kstep;
            PG8_KPAIR(PG8_MMA0, PG8_LDB(B0a, 0, 0), PG8_LDB(B0a, 0, 0));
        }
        for (int t = 2; t < nt - 2; t += 2) {
            const char* a1 = cA + (size_t)(t + 1) * kstep;
            const char* a2 = cA + (size_t)(t + 2) * kstep; const char* b2 = cB + (size_t)(t + 2) * kstep;
            const char* a3 = a2 + kstep; const char* b3 = b2 + kstep;
            PG8_KPAIR(PG8_MMA, PG8_NOTHING, PG8_LDB(B0a, 0, 0));
        }
        {
            const char* a1 = cA + (size_t)(nt - 1) * kstep;
            const char* a2 = nA; const char* b2 = nB; const char* a3 = a2 + kstep; const char* b3 = b2 + kstep;
            if (has_next) S.a_ready(nxt);
            PG8_KPAIR(PG8_MMA, PG8_NOTHING, PG8_NOTHING);
        }
#undef PG8_NOTHING
#undef PG8_KPAIR
        } else {
#define PG8_KPAIR(MMAX) do { \
            PG8_LDB(B0, 0, 0); PG8_LDB(B1, 0, 1); PG8_SCHED; PG8_LDA(At, 0, 0); PG8_STAGE(PG8_SA(1, 1), a1 + hstep, voffA); \
            PG8_WAIT_V(8); PG8_WAIT_L(0); PG8_BAR; MMAX(0, 0, At, B0); MMAX(0, 1, At, B1); PG8_BAR; PG8_SCHED; \
            PG8_LDA(At, 0, 1); PG8_STAGE(PG8_SB(0, 0), b2, voffB); PG8_STAGE(PG8_SB(0, 1), b2 + hstep, voffB); PG8_STAGE(PG8_SA(0, 0), a2, voffA); \
            PG8_WAIT_V(8); PG8_WAIT_L(0); PG8_BAR; MMAX(1, 0, At, B0); MMAX(1, 1, At, B1); PG8_BAR; PG8_SCHED; \
            PG8_LDB(B0, 1, 0); PG8_LDB(B1, 1, 1); PG8_SCHED; PG8_LDA(At, 1, 0); PG8_STAGE(PG8_SA(0, 1), a2 + hstep, voffA); \
            PG8_WAIT_V(8); PG8_WAIT_L(0); PG8_BAR; PG8_MMA(0, 0, At, B0); PG8_MMA(0, 1, At, B1); PG8_BAR; PG8_SCHED; \
            PG8_LDA(At, 1, 1); PG8_STAGE(PG8_SB(1, 0), b3, voffB); PG8_STAGE(PG8_SB(1, 1), b3 + hstep, voffB); PG8_STAGE(PG8_SA(1, 0), a3, voffA); \
            PG8_WAIT_V(8); PG8_WAIT_L(0); PG8_BAR; PG8_MMA(1, 0, At, B0); PG8_MMA(1, 1, At, B1); PG8_BAR; PG8_SCHED; } while (0)
        {
            const char* a1 = cA + kstep; const char* a2 = cA + 2 * kstep; const char* b2 = cB + 2 * kstep; const char* a3 = a2 + kstep; const char* b3 = b2 + kstep;
            PG8_KPAIR(PG8_MMA0);
        }
        for (int t = 2; t < nt; t += 2) {
            const bool last = (t == nt - 2);
            const char* a1 = cA + (size_t)(t + 1) * kstep;
            const char* a2 = last ? nA : cA + (size_t)(t + 2) * kstep; const char* b2 = last ? nB : cB + (size_t)(t + 2) * kstep;
            const char* a3 = a2 + kstep; const char* b3 = b2 + kstep;
            if (last && has_next) S.a_ready(nxt);
            PG8_KPAIR(PG8_MMA);
        }
#undef PG8_KPAIR
        }
        if constexpr (ALIGN_EPI) { if (wr == 0) PG8_BAR; }
        if constexpr (F8) asm volatile("s_nop 15\n\ts_nop 15" ::: "memory");
        if constexpr (!Epi::AFTER_DRAIN) { E(acc, cur, wr, wc, fr, fq); S.done(cur); }
        if (!has_next) break;
        cur = nxt; cA = nA; cB = nB; ++ui;
        if constexpr (ALIGN_EPI) { if (wr == 1) PG8_BAR; }
    }
    PG8_WAIT_V(0);
    if constexpr (!ALIGN_EPI) { if (wr == 0) PG8_BAR; }
    PG8_BAR;
    if constexpr (Epi::AFTER_DRAIN) { E.fused(acc, cur, wr, wc, fr, fq, lds, wid, lane); S.done(cur); }
#undef PG8_SA
#undef PG8_SB
#undef PG8_STAGE
#undef PG8_LDA
#undef PG8_LDB
#undef PG8_MMA
#undef PG8_MMA0
#undef PG8_LD32
#undef PG8_WAIT_V
#undef PG8_WAIT_L
#undef PG8_BAR
#undef PG8_SCHED
}
}

#define GAS __attribute__((address_space(1)))
#define LAS __attribute__((address_space(3)))
typedef unsigned short bf16;
typedef unsigned v4u __attribute__((ext_vector_type(4)));
typedef float f32x4 __attribute__((ext_vector_type(4)));
typedef short bf16x8 __attribute__((ext_vector_type(8)));
typedef GAS unsigned gu32;
typedef GAS unsigned long long gu64;
#define RLX_AGENT __ATOMIC_RELAXED, __HIP_MEMORY_SCOPE_AGENT
#define LDS_WAIT() asm volatile("s_waitcnt lgkmcnt(0)" ::: "memory")
#define VM_WAIT() asm volatile("s_waitcnt vmcnt(0)" ::: "memory")
__device__ __forceinline__ unsigned long long rt() { return __builtin_amdgcn_s_memrealtime(); }
__device__ __forceinline__ unsigned f2bf(float f) { unsigned u = __builtin_bit_cast(unsigned, f); return (u + 0x7fffu + ((u >> 16) & 1u)) >> 16; }
__device__ __forceinline__ unsigned pk2(float lo, float hi) { return f2bf(lo) | (f2bf(hi) << 16); }

#define XB_TMO      128
#define XB_XCNT(j)  (256  + 64 * (j))
#define XB_XSUB(j)  (1280 + 64 * (j))
#define XB_XGEN(j)  (2304 + 64 * (j))
#define XB_TOP      3328
#define XB_TOPGEN   3392
#define XCD_BAR_WORDS 3456
#define XB_SPIN_CAP (1u << 18)

__device__ __forceinline__ unsigned xb_ld(unsigned* p)              { return __hip_atomic_load(p, __ATOMIC_RELAXED, __HIP_MEMORY_SCOPE_AGENT); }
__device__ __forceinline__ unsigned xb_add(unsigned* p, unsigned v) { return __hip_atomic_fetch_add(p, v, __ATOMIC_RELAXED, __HIP_MEMORY_SCOPE_AGENT); }
__device__ __forceinline__ unsigned xb_xcc_id() { return (unsigned)__builtin_amdgcn_s_getreg((3 << 11) | 20) & 0xFu; }
#define XB_SPIN(cond, bar) do { unsigned _sp = 0; while (cond) { __builtin_amdgcn_s_sleep(1); \
    if ((++_sp & 255u) == 0u) { if (xb_ld(&(bar)[XB_TMO])) break; if (_sp > XB_SPIN_CAP) { atomicAdd(&(bar)[XB_TMO], 1u); break; } } } } while (0)

struct XcdBarrier {
    unsigned* bar; unsigned x;
    volatile LAS unsigned* st;
};

__device__ __forceinline__ XcdBarrier xcd_barrier_post(unsigned* bar, volatile LAS unsigned* st) {
    XcdBarrier b; b.bar = bar; b.x = xb_xcc_id(); b.st = st;
    if (threadIdx.x == 0) (void)xb_add(&bar[XB_XCNT(b.x)], 1u);
    return b;
}
__device__ __forceinline__ void xcd_barrier_complete(unsigned* bar, unsigned x, unsigned& nloc, unsigned& nx) {
    const unsigned G = gridDim.x * gridDim.y * gridDim.z;
    unsigned sum, cnt, mine, sp = 0u;
    for (;;) {
        sum = 0u; cnt = 0u; mine = 0u;
#pragma unroll
        for (unsigned j = 0; j < 16; ++j) { const unsigned c = xb_ld(&bar[XB_XCNT(j)]); sum += c; cnt += (c > 0u) ? 1u : 0u; mine = (j == x) ? c : mine; }
        if (sum == G) break;
        __builtin_amdgcn_s_sleep(1);
        if ((++sp & 255u) == 0u) { if (xb_ld(&bar[XB_TMO])) break; if (sp > XB_SPIN_CAP) { atomicAdd(&bar[XB_TMO], 1u); break; } }
    }
    nloc = mine > 0u ? mine : 1u; nx = cnt > 0u ? cnt : 1u;
}

__device__ __forceinline__ void xcd_barrier(const XcdBarrier& b) {
    asm volatile("s_waitcnt vmcnt(0)" ::: "memory");
    __syncthreads();
    if (threadIdx.x == 0) {
        unsigned* bar = b.bar;
        __builtin_amdgcn_s_waitcnt(0);
        unsigned nloc = b.st[0], nx = b.st[1];
        if (nloc == 0u) { xcd_barrier_complete(bar, b.x, nloc, nx); b.st[0] = nloc; b.st[1] = nx; }
        const unsigned old = xb_add(&bar[XB_XSUB(b.x)], 1u);
        const unsigned gen = old / nloc;
        if (old + 1u == (gen + 1u) * nloc) {
            __builtin_amdgcn_fence(__ATOMIC_RELEASE, "agent");
            asm volatile("s_waitcnt vmcnt(0)" ::: "memory");
            const unsigned og = xb_add(&bar[XB_TOP], 1u);
            const unsigned tg = og / nx;
            if (og + 1u == (tg + 1u) * nx) xb_add(&bar[XB_TOPGEN], 1u);
            else XB_SPIN(xb_ld(&bar[XB_TOPGEN]) == tg, bar);
            __builtin_amdgcn_fence(__ATOMIC_ACQUIRE, "agent");
            xb_add(&bar[XB_XGEN(b.x)], 1u);
            asm volatile("s_waitcnt vmcnt(0)" ::: "memory");
        } else {
            XB_SPIN(xb_ld(&bar[XB_XGEN(b.x)]) == gen, bar);
            __builtin_amdgcn_fence(__ATOMIC_ACQUIRE, "agent");
            asm volatile("s_waitcnt vmcnt(0)" ::: "memory");
        }
    }
    __syncthreads();
}

__device__ const double INV_FREQ[64] = {1.0, 0.8659643233600653, 0.7498942093324559, 0.6493816315762113, 0.5623413251903491, 0.4869675251658631, 0.4216965034285822, 0.3651741272548377, 0.31622776601683794, 0.27384196342643613, 0.23713737056616552, 0.2053525026457146, 0.1778279410038923, 0.1539926526059492, 0.1333521432163324, 0.11547819846894582, 0.1, 0.08659643233600653, 0.07498942093324558, 0.06493816315762113, 0.05623413251903491, 0.04869675251658631, 0.042169650342858224, 0.03651741272548377, 0.03162277660168379, 0.027384196342643614, 0.023713737056616554, 0.02053525026457146, 0.01778279410038923, 0.01539926526059492, 0.01333521432163324, 0.011547819846894581, 0.01, 0.008659643233600654, 0.007498942093324558, 0.006493816315762113, 0.005623413251903491, 0.004869675251658631, 0.004216965034285823, 0.003651741272548377, 0.0031622776601683794, 0.0027384196342643613, 0.0023713737056616554, 0.002053525026457146, 0.0017782794100389228, 0.001539926526059492, 0.001333521432163324, 0.0011547819846894581, 0.001, 0.0008659643233600654, 0.0007498942093324559, 0.0006493816315762113, 0.0005623413251903491, 0.0004869675251658631, 0.00042169650342858224, 0.0003651741272548377, 0.00031622776601683794, 0.0002738419634264361, 0.00023713737056616554, 0.0002053525026457146, 0.00017782794100389227, 0.0001539926526059492, 0.0001333521432163324, 0.00011547819846894582};
#define PG8_SP2 true
#define PG8_ALIGN true
constexpr int NWAVES = 8;
constexpr int BATCH = 4, SEQ = 4096, D = 4096, FF = 11008, M = BATCH * SEQ, NPROJ = 12288, NPROJ_ALL = 12296, CH = 128, NCH = SEQ / CH;
constexpr int RH = 8, RDK = 128, RDV = 256, MH = 4, MDK = 256, MDV = 512, MVR = 528  ;
constexpr float NORM_EPS = 1e-6f;
constexpr int C_RQ = 0, C_RK = 1024, C_RV = 2048, C_RG = 4096, C_MQ = 6144, C_MK = 7168, C_MV = 8192, C_MO = 10240;
constexpr size_t MiB = 1u << 20;
constexpr size_t WS_CTL = 0, CTL_ZERO_BYTES = 32768;
constexpr size_t WS_ROT = 1 * MiB;
constexpr size_t WS_GI = 3 * MiB;
constexpr size_t WS_LF = WS_GI + 256 * 1024;
constexpr size_t WS_WG8 = WS_LF + 256 * 1024;
constexpr size_t WS_CHS = WS_WG8 + 128 * 1024;
constexpr size_t WS_MP = WS_CHS + 4096;
constexpr size_t WS_ST_R = 8 * MiB;
constexpr size_t WS_ST_M = 72 * MiB;
constexpr size_t WS_WGU1 = 8 * MiB;
constexpr size_t WS_WD1 = 180 * MiB;
constexpr size_t WS_WIN = 266 * MiB;
constexpr size_t WS_WOUT = 362 * MiB;
constexpr size_t WS_WGU2 = 394 * MiB;
constexpr size_t WS_WD2 = 566 * MiB;
constexpr size_t WS_XN = 652 * MiB;
constexpr size_t WS_BIG = 780 * MiB;
constexpr int GU8 = 18;
constexpr size_t WS_XN8 = WS_BIG + 192 * MiB;
constexpr size_t WS_RES = 1164 * MiB;
constexpr size_t WS_END = 1292 * MiB;
static_assert(WS_ST_M + (size_t)16 * 32 * MVR * MDK * 2 <= WS_WIN && WS_ST_R + (size_t)32 * 32 * RDV * RDK * 2 <= WS_ST_M, "state overlay");
static_assert(WS_BIG + (size_t)M * NPROJ * 2 <= WS_END && WS_XN8 >= WS_BIG + (size_t)M * FF && WS_XN8 + (size_t)M * D <= WS_RES, "ws map");
constexpr int CW_BAR = 4096;
constexpr int RING_OFF = 0, RING_BYTES = 131072;
constexpr int SM_OFF = 139264;
constexpr int LDSCTL_OFF = 141312, MISC_OFF = LDSCTL_OFF + 320;
constexpr int LDS_BYTES = 147456;
static_assert(MISC_OFF + 128 <= LDS_BYTES, "LDS map");

typedef short s16x4 __attribute__((ext_vector_type(4)));
typedef float f32x2 __attribute__((ext_vector_type(2)));
typedef unsigned v2u __attribute__((ext_vector_type(2)));
struct Frame {
    LAS unsigned char* lds;
    volatile LAS unsigned* MISC;
    gu32* ctl;
    int tid, lane, wave;
    int vcu, G;
    const float* in[19]; float* out; unsigned char* ws;
};
__device__ __forceinline__ float wave_sum(float v) {
#pragma unroll
    for (int o = 1; o < 64; o <<= 1) v += __shfl_xor(v, o);
    return v;
}
__device__ __forceinline__ float bf2f(short s) { return __builtin_bit_cast(float, ((unsigned)(unsigned short)s) << 16); }
__device__ __forceinline__ float bflo(unsigned w) { return __builtin_bit_cast(float, w << 16); }
__device__ __forceinline__ float bfhi(unsigned w) { return __builtin_bit_cast(float, w & 0xffff0000u); }
__device__ __forceinline__ size_t blk_off(int r, int k, int nkt) { return ((size_t)((r >> 8) * nkt + (k >> 6)) * 256 + (r & 255)) * 64 + (k & 63); }

__device__ __forceinline__ const bf16* head_ptr(const unsigned char* ws, int seg_start, int hw, int H, int b, int h) { return (const bf16*)(ws + WS_BIG) + (size_t)seg_start * M + (size_t)(b * H + h) * SEQ * hw; }
__device__ __forceinline__ void transpose_item(const float* W, int ldw, int k0, int n0, bf16* WT, int nr0, int K, LAS float* scr, int lane) {
    f32x4 v[8];
#pragma unroll
    for (int i = 0; i < 8; ++i) { const int kk = 8 * i + (lane >> 3); v[i] = __builtin_nontemporal_load((const GAS f32x4*)(W + (size_t)(k0 + kk) * ldw + n0 + 4 * (lane & 7))); }
#pragma unroll
    for (int i = 0; i < 8; ++i) { const int kk = 8 * i + (lane >> 3); LAS float* p = scr + kk * 33 + 4 * (lane & 7); p[0] = v[i].x; p[1] = v[i].y; p[2] = v[i].z; p[3] = v[i].w; }
    LDS_WAIT(); asm volatile("" ::: "memory");
    const int c = lane & 7;
#pragma unroll
    for (int j = 0; j < 4; ++j) { const int n = (lane >> 3) + 8 * j; const LAS float* s = scr + (8 * c) * 33 + n;
        v4u o; o.x = pk2(s[0 * 33], s[1 * 33]); o.y = pk2(s[2 * 33], s[3 * 33]); o.z = pk2(s[4 * 33], s[5 * 33]); o.w = pk2(s[6 * 33], s[7 * 33]);
        *(GAS v4u*)(WT + blk_off(nr0 + n, k0 + 8 * c, K >> 6)) = o; }
    LDS_WAIT(); asm volatile("" ::: "memory");
}
__device__ __forceinline__ void transpose_item8(const float* W, int ldw, int k0, int n0, unsigned char* WT8, int nr0, int K, LAS float* scr, int lane, float sc) {
    f32x4 v[8];
#pragma unroll
    for (int i = 0; i < 8; ++i) { const int kk = 8 * i + (lane >> 3); v[i] = __builtin_nontemporal_load((const GAS f32x4*)(W + (size_t)(k0 + kk) * ldw + n0 + 4 * (lane & 7))); }
#pragma unroll
    for (int i = 0; i < 8; ++i) { const int kk = 8 * i + (lane >> 3); LAS float* p = scr + kk * 33 + 4 * (lane & 7); p[0] = v[i].x; p[1] = v[i].y; p[2] = v[i].z; p[3] = v[i].w; }
    LDS_WAIT(); asm volatile("" ::: "memory");
    const int c = lane & 3;
#pragma unroll
    for (int j = 0; j < 2; ++j) { const int n = (lane >> 2) + 16 * j; const LAS float* s = scr + (16 * c) * 33 + n;
        v4u o;
        o.x = pg8::pack4_fp8(sc * s[0 * 33], sc * s[1 * 33], sc * s[2 * 33], sc * s[3 * 33]); o.y = pg8::pack4_fp8(sc * s[4 * 33], sc * s[5 * 33], sc * s[6 * 33], sc * s[7 * 33]);
        o.z = pg8::pack4_fp8(sc * s[8 * 33], sc * s[9 * 33], sc * s[10 * 33], sc * s[11 * 33]); o.w = pg8::pack4_fp8(sc * s[12 * 33], sc * s[13 * 33], sc * s[14 * 33], sc * s[15 * 33]);
        *(GAS v4u*)(WT8 + pg8::blk8_off(nr0 + n, k0 + 16 * c, K >> 7)) = o; }
    LDS_WAIT(); asm volatile("" ::: "memory");
}
__device__ __forceinline__ void transpose_plain8(const float* W, int K, int N, int ldw, unsigned char* WT8, LAS float* scr, int item, int lane, float sc) {
    const int nblk = N / 32, kb = item / nblk, nb = item % nblk;
    transpose_item8(W, ldw, 64 * kb, 32 * nb, WT8, 32 * nb, K, scr, lane, sc);
}
__device__ __forceinline__ void transpose_gu8(const float* W, int half, unsigned char* WT8, LAS float* scr, int kb, int n0, int lane, float sc) {
    transpose_item8(W, FF, 64 * kb, n0, WT8, (n0 >> 7) * 256 + half * 128 + (n0 & 127), D, scr, lane, sc);
}
__device__ __forceinline__ void transpose_plain(const float* W, int K, int N, int ldw, bf16* WT, LAS float* scr, int item, int lane) {
    const int nblk = N / 32, kb = item / nblk, nb = item % nblk;
    transpose_item(W, ldw, 64 * kb, 32 * nb, WT, 32 * nb, K, scr, lane);
}
__device__ __forceinline__ void transpose_gu(const float* W, int half, bf16* WT, LAS float* scr, int item, int lane) {
    const int nblk = FF / 32, kb = item / nblk, nb = item % nblk, n0 = 32 * nb;
    transpose_item(W, FF, 64 * kb, n0, WT, (n0 >> 7) * 256 + half * 128 + (n0 & 127), D, scr, lane);
}
struct TItem { const float* W; bf16* WT; int ldw, k0, n0, nr0, K; };
__device__ __forceinline__ TItem titem_plain(const float* W, int K, int N, int ldw, bf16* WT, int item) {
    const int nblk = N / 32, kb = item / nblk, nb = item % nblk; TItem t; t.W = W; t.WT = WT; t.ldw = ldw; t.k0 = 64 * kb; t.n0 = 32 * nb; t.nr0 = 32 * nb; t.K = K; return t; }
__device__ __forceinline__ TItem titem_gu(const float* W, int half, bf16* WT, int item) {
    const int nblk = FF / 32, kb = item / nblk, nb = item % nblk, n0 = 32 * nb; TItem t; t.W = W; t.WT = WT; t.ldw = FF; t.k0 = 64 * kb; t.n0 = n0; t.nr0 = (n0 >> 7) * 256 + half * 128 + (n0 & 127); t.K = D; return t; }
__device__ __forceinline__ void titem_load(const TItem& t, f32x4 (&v)[8], int lane) {
#pragma unroll
    for (int i = 0; i < 8; ++i) { const int kk = 8 * i + (lane >> 3); v[i] = *(const GAS f32x4*)(t.W + (size_t)(t.k0 + kk) * t.ldw + t.n0 + 4 * (lane & 7)); }
}
__device__ __forceinline__ void titem_process(const TItem& t, const f32x4 (&v)[8], LAS float* scr, int lane) {
#pragma unroll
    for (int i = 0; i < 8; ++i) { const int kk = 8 * i + (lane >> 3); LAS float* p = scr + kk * 33 + 4 * (lane & 7); p[0] = v[i].x; p[1] = v[i].y; p[2] = v[i].z; p[3] = v[i].w; }
    LDS_WAIT(); asm volatile("" ::: "memory");
    const int c = lane & 7;
#pragma unroll
    for (int j = 0; j < 4; ++j) { const int n = (lane >> 3) + 8 * j; const LAS float* s = scr + (8 * c) * 33 + n;
        v4u o; o.x = pk2(s[0 * 33], s[1 * 33]); o.y = pk2(s[2 * 33], s[3 * 33]); o.z = pk2(s[4 * 33], s[5 * 33]); o.w = pk2(s[6 * 33], s[7 * 33]);
        *(GAS v4u*)(t.WT + blk_off(t.nr0 + n, t.k0 + 8 * c, t.K >> 6)) = o; }
    LDS_WAIT(); asm volatile("" ::: "memory");
}
template <int MODE>
__device__ __forceinline__ void norm_row(const float* xrow, const float* g, bf16* obase, int row, float* frow, const LAS float* wg, float (&gd)[8], int lane) {
    const GAS f32x4* xr = (const GAS f32x4*)xrow + lane; const GAS f32x4* gr = (const GAS f32x4*)g + lane;
    f32x4 v[16]; float s = 0.f;
#pragma unroll
    for (int j = 0; j < 16; ++j) { v[j] = xr[64 * j]; s += (v[j].x * v[j].x + v[j].y * v[j].y) + (v[j].z * v[j].z + v[j].w * v[j].w); }
    const float rstd = 1.0f / sqrtf(wave_sum(s) * (1.0f / D) + NORM_EPS);
#pragma unroll
    for (int hh = 0; hh < 8; ++hh) gd[hh] = 0.f;
#pragma unroll
    for (int j = 0; j < 16; ++j) {
        const f32x4 gv = gr[64 * j]; const f32x4 y = v[j] * rstd * gv;
        if (MODE == 2) { ((GAS f32x4*)frow + lane)[64 * j] = y; }
        else { v2u o; o.x = pk2(y.x, y.y); o.y = pk2(y.z, y.w); *(GAS v2u*)(obase + blk_off(row, 4 * lane + 256 * j, D >> 6)) = o; }
        if (MODE == 1) {
#pragma unroll
            for (int hh = 0; hh < 8; ++hh) { const f32x4 w = *(const LAS f32x4*)(wg + hh * D + 4 * lane + 256 * j); gd[hh] += (y.x * w.x + y.y * w.y) + (y.z * w.z + y.w * w.w); }
            asm volatile("" ::: "memory");
        }
    }
}
template <int MODE, bool X8 = false>
__device__ __forceinline__ void norm_row_bf(const bf16* xrow, const float* g, bf16* obase, int row, float* frow, const LAS float* wg, float (&gd)[8], int lane, unsigned char* o8 = nullptr) {
    const GAS v4u* xr = (const GAS v4u*)xrow + lane; const GAS f32x4* gr = (const GAS f32x4*)g + 2 * lane;
    v4u xv[8]; float s = 0.f;
#pragma unroll
    for (int j = 0; j < 8; ++j) { xv[j] = xr[64 * j];
        const float a0 = bflo(xv[j].x), a1 = bfhi(xv[j].x), a2 = bflo(xv[j].y), a3 = bfhi(xv[j].y), a4 = bflo(xv[j].z), a5 = bfhi(xv[j].z), a6 = bflo(xv[j].w), a7 = bfhi(xv[j].w);
        s += ((a0 * a0 + a1 * a1) + (a2 * a2 + a3 * a3)) + ((a4 * a4 + a5 * a5) + (a6 * a6 + a7 * a7)); }
    const float rstd = 1.0f / sqrtf(wave_sum(s) * (1.0f / D) + NORM_EPS);
#pragma unroll
    for (int hh = 0; hh < 8; ++hh) gd[hh] = 0.f;
#pragma unroll
    for (int j = 0; j < 8; ++j) {
        const f32x4 g0 = gr[128 * j], g1 = gr[128 * j + 1];
        const f32x4 y0 = (f32x4){bflo(xv[j].x), bfhi(xv[j].x), bflo(xv[j].y), bfhi(xv[j].y)} * rstd * g0, y1 = (f32x4){bflo(xv[j].z), bfhi(xv[j].z), bflo(xv[j].w), bfhi(xv[j].w)} * rstd * g1;
        if (MODE == 2) { GAS f32x4* fo = (GAS f32x4*)frow + 2 * (lane + 64 * j); fo[0] = y0; fo[1] = y1; }
        else { v4u o; o.x = pk2(y0.x, y0.y); o.y = pk2(y0.z, y0.w); o.z = pk2(y1.x, y1.y); o.w = pk2(y1.z, y1.w); *(GAS v4u*)(obase + blk_off(row, 8 * (lane + 64 * j), D >> 6)) = o; }
        if (X8) { v2u o; o.x = pg8::pack4_fp8(pg8::F8_X_SCALE * y0.x, pg8::F8_X_SCALE * y0.y, pg8::F8_X_SCALE * y0.z, pg8::F8_X_SCALE * y0.w); o.y = pg8::pack4_fp8(pg8::F8_X_SCALE * y1.x, pg8::F8_X_SCALE * y1.y, pg8::F8_X_SCALE * y1.z, pg8::F8_X_SCALE * y1.w);
            *(GAS v2u*)(o8 + pg8::blk8_off(row, 8 * (lane + 64 * j), D >> 7)) = o; }
        if (MODE == 1) {
#pragma unroll
            for (int hh = 0; hh < 8; ++hh) { const LAS f32x4* wp = (const LAS f32x4*)(wg + hh * D + 8 * (lane + 64 * j)); const f32x4 w0 = wp[0], w1 = wp[1];
                gd[hh] += ((y0.x * w0.x + y0.y * w0.y) + (y0.z * w0.z + y0.w * w0.w)) + ((y1.x * w1.x + y1.y * w1.y) + (y1.z * w1.z + y1.w * w1.w)); }
            asm volatile("" ::: "memory");
        }
    }
}
__device__ __forceinline__ float log_sigmoid(float x) { return fminf(x, 0.f) - log1pf(__expf(-fabsf(x))); }

#define MFMA16(a, b, c) __builtin_amdgcn_mfma_f32_16x16x32_bf16((a), (b), (c), 0, 0, 0)
__device__ __forceinline__ bf16x8 tr_frag(const LAS unsigned char* base, int pitch, int k0, int n0, int lane) {
    const int g = lane >> 4, q = (lane & 15) >> 2, p = lane & 3;
    const LAS unsigned char* a = base + ((k0 + 8 * g + q) * pitch + n0 + 4 * p) * 2;
    const s16x4 lo = __builtin_amdgcn_ds_read_tr16_b64_v4i16((LAS s16x4*)a);
    const s16x4 hi = __builtin_amdgcn_ds_read_tr16_b64_v4i16((LAS s16x4*)(a + 8 * pitch));
    bf16x8 r; r[0] = lo[0]; r[1] = lo[1]; r[2] = lo[2]; r[3] = lo[3]; r[4] = hi[0]; r[5] = hi[1]; r[6] = hi[2]; r[7] = hi[3]; return r;
}
constexpr int PV_PITCH = 136;
constexpr int VS_BYTES = 128 * PV_PITCH * 2;
__device__ __forceinline__ void stage_v(LAS unsigned char* dst, const bf16* hp, int pitch, int pos0, int col, int tid) {
#pragma unroll
    for (int it = 0; it < 4; ++it) { const int p = tid + 512 * it, j = p >> 4, ch = p & 15;
        const v4u x = *(const GAS v4u*)(hp + (size_t)(pos0 + j) * pitch + col + 8 * ch);
        *(LAS v4u*)(dst + (j * PV_PITCH + 8 * ch) * 2) = x; }
}
__device__ __forceinline__ void stage_rot(LAS unsigned char* dst, const bf16* hp, const float* rot, int pos0, float scale, float lgk, int tid) {
    const int j = tid >> 2, q = tid & 3;
    const bf16* p = hp + (size_t)(pos0 + j) * 128 + 16 * q;
    const bf16x8 x1a = *(const GAS bf16x8*)p, x1b = *(const GAS bf16x8*)(p + 8), x2a = *(const GAS bf16x8*)(p + 64), x2b = *(const GAS bf16x8*)(p + 72);
    const GAS f32x4* rt = (const GAS f32x4*)(rot + ((size_t)(pos0 + j) * 64 + 16 * q) * 2);
    f32x4 cs[8];
#pragma unroll
    for (int i = 0; i < 8; ++i) cs[i] = rt[i];
    const float mul = scale * (lgk != 0.f ? __expf(lgk * (float)(127 - j)) : 1.0f);
    float y1[16], y2[16];
#pragma unroll
    for (int e = 0; e < 16; ++e) { const float a = bf2f(e < 8 ? x1a[e] : x1b[e - 8]), b = bf2f(e < 8 ? x2a[e] : x2b[e - 8]);
        const float c = cs[e >> 1][(e & 1) * 2], s = cs[e >> 1][(e & 1) * 2 + 1];
        y1[e] = (a * c - b * s) * mul; y2[e] = (a * s + b * c) * mul; }
    LAS unsigned char* o = dst + (j * PV_PITCH + 16 * q) * 2;
    v4u w;
    w.x = pk2(y1[0], y1[1]); w.y = pk2(y1[2], y1[3]); w.z = pk2(y1[4], y1[5]); w.w = pk2(y1[6], y1[7]); *(LAS v4u*)o = w;
    w.x = pk2(y1[8], y1[9]); w.y = pk2(y1[10], y1[11]); w.z = pk2(y1[12], y1[13]); w.w = pk2(y1[14], y1[15]); *(LAS v4u*)(o + 16) = w;
    w.x = pk2(y2[0], y2[1]); w.y = pk2(y2[2], y2[3]); w.z = pk2(y2[4], y2[5]); w.w = pk2(y2[6], y2[7]); *(LAS v4u*)(o + 128) = w;
    w.x = pk2(y2[8], y2[9]); w.y = pk2(y2[10], y2[11]); w.z = pk2(y2[12], y2[13]); w.w = pk2(y2[14], y2[15]); *(LAS v4u*)(o + 144) = w;
}
constexpr int MK_PITCH = 264;
__device__ __forceinline__ void stage_conv(LAS unsigned char* dst, const bf16* hp, const float* cw, const float* cb, int t0, int cch, float scale, const LAS float* rw, int tid) {
    const int dch = tid & 31, jg = tid >> 5, d0 = 8 * dch;
    float w[4][8], bias[8];
#pragma unroll
    for (int k = 0; k < 4; ++k) { const f32x4 a = *(const GAS f32x4*)(cw + k * 2048 + cch + d0), b = *(const GAS f32x4*)(cw + k * 2048 + cch + d0 + 4);
        w[k][0] = a.x; w[k][1] = a.y; w[k][2] = a.z; w[k][3] = a.w; w[k][4] = b.x; w[k][5] = b.y; w[k][6] = b.z; w[k][7] = b.w; }
    { const f32x4 a = *(const GAS f32x4*)(cb + cch + d0), b = *(const GAS f32x4*)(cb + cch + d0 + 4);
        bias[0] = a.x; bias[1] = a.y; bias[2] = a.z; bias[3] = a.w; bias[4] = b.x; bias[5] = b.y; bias[6] = b.z; bias[7] = b.w; }
    bf16x8 x[11];
#pragma unroll
    for (int r = 0; r < 11; ++r) { const int t = t0 + 8 * jg + r - 3;
        if (t >= 0) x[r] = *(const GAS bf16x8*)(hp + (size_t)t * 256 + d0); else x[r] = (bf16x8){0, 0, 0, 0, 0, 0, 0, 0}; }
#pragma unroll
    for (int jj = 0; jj < 8; ++jj) {
        const float rs = scale * (rw ? rw[8 * jg + jj] : 1.0f);
        float y[8];
#pragma unroll
        for (int e = 0; e < 8; ++e) { float a = bias[e];
#pragma unroll
            for (int k = 0; k < 4; ++k) a += w[k][e] * bf2f(x[jj + k][e]);
            y[e] = a * __builtin_amdgcn_rcpf(1.0f + __expf(-a)) * rs; }
        v4u o; o.x = pk2(y[0], y[1]); o.y = pk2(y[2], y[3]); o.z = pk2(y[4], y[5]); o.w = pk2(y[6], y[7]);
        *(LAS v4u*)(dst + ((8 * jg + jj) * MK_PITCH + d0) * 2) = o; }
}
__device__ __forceinline__ void gate_scan(const float* GI, const float* LF, int row0, int h, float mprev, LAS float* sA, LAS float* sB, LAS float* sG, float& amax, float& blast, int lane) {
    const int r = row0 + 2 * lane;
    const float f0 = LF[(size_t)r * 4 + h], f1 = LF[(size_t)(r + 1) * 4 + h], i0 = GI[(size_t)r * 4 + h], i1 = GI[(size_t)(r + 1) * 4 + h];
    const float s = f0 + f1; float incl = s;
#pragma unroll
    for (int o = 1; o < 64; o <<= 1) { const float t = __shfl_up(incl, o); if (lane >= o) incl += t; }
    const float b0 = (incl - s) + f0, b1 = b0 + f1, a0 = i0 - b0, a1 = i1 - b1;
    float cm = fmaxf(a0, a1);
#pragma unroll
    for (int o = 1; o < 64; o <<= 1) { const float t = __shfl_up(cm, o); if (lane >= o) cm = fmaxf(cm, t); }
    float pe = __shfl_up(cm, 1); if (lane == 0) pe = -__builtin_inff();
    const float g0 = fmaxf(fmaxf(mprev, pe), a0), g1 = fmaxf(g0, a1);
    sA[2 * lane] = a0; sA[2 * lane + 1] = a1; sB[2 * lane] = b0; sB[2 * lane + 1] = b1; sG[2 * lane] = g0; sG[2 * lane + 1] = g1;
    amax = __shfl(cm, 63); blast = __shfl(b1, 63);
}
__device__ __forceinline__ float ret_log_gamma(int h) { return log1pf(-exp2f(-5.0f - (float)h)); }

template <bool ML>
__device__ __forceinline__ void phaseA_unit(Frame& F, int u) {
    constexpr int H = ML ? MH : RH, DK = ML ? MDK : RDK, DV = ML ? MDV : RDV, NSL = DV / 128, DT = DK / 128, VR = ML ? MVR : RDV, PK = ML ? MK_PITCH : PV_PITCH;
    constexpr int KB = 128 * PK * 2;
    int tid_ = F.tid; asm volatile("" : "+v"(tid_));
    const int b = u / (H * NCH), h = (u / NCH) % H, c = u % NCH, row0 = b * SEQ + c * CH, tid = tid_, lane = tid & 63, wave = F.wave;
    const bf16* proj = (const bf16*)(F.ws + WS_BIG);
    LAS unsigned char* kreg = F.lds; LAS unsigned char* vreg = F.lds + KB;
    LAS float* sA = (LAS float*)(F.lds + SM_OFF); LAS float* sB = sA + 128; LAS float* sG = sA + 256; LAS float* sW = sA + 384;
    bf16* st = (bf16*)(F.ws + (ML ? WS_ST_M : WS_ST_R)) + (size_t)u * VR * DK;
    const bf16* vhp = ML ? head_ptr(F.ws, C_MV, MDV, MH, b, h) : head_ptr(F.ws, C_RV, RDV, RH, b, h);
    v4u vpre[4];
#define PA_LOAD_V(sl_) do { _Pragma("unroll") for (int it = 0; it < 4; ++it) { const int p_ = tid + 512 * it, j_ = p_ >> 4, ch_ = p_ & 15; vpre[it] = *(const GAS v4u*)(vhp + (size_t)(c * CH + j_) * DV + 128 * (sl_) + 8 * ch_); } } while (0)
#define PA_WRITE_V() do { _Pragma("unroll") for (int it = 0; it < 4; ++it) { const int p_ = tid + 512 * it, j_ = p_ >> 4, ch_ = p_ & 15; *(LAS v4u*)(vreg + (j_ * PV_PITCH + 8 * ch_) * 2) = vpre[it]; } } while (0)
    PA_LOAD_V(0);
    if (ML) {
        if (wave == 0) { float amax, blast; gate_scan((const float*)(F.ws + WS_GI), (const float*)(F.ws + WS_LF), row0, h, -__builtin_inff(), sA, sB, sG, amax, blast, lane);
            sW[2 * lane] = __expf(sA[2 * lane] - amax); sW[2 * lane + 1] = __expf(sA[2 * lane + 1] - amax);
            if (lane == 0) { float* chs = (float*)(F.ws + WS_CHS) + 2 * u; chs[0] = amax; chs[1] = blast; } }
        __syncthreads();
        stage_conv(kreg, head_ptr(F.ws, C_MK, MDK, MH, b, h), F.in[7], F.in[8], c * CH, 1024 + MDK * h, 0.0625f, sW, tid);
    } else {
        stage_rot(kreg, head_ptr(F.ws, C_RK, RDK, RH, b, h), (const float*)(F.ws + WS_ROT), c * CH, 0.08838834764831845f, ret_log_gamma(h), tid);
    }
    const int g = lane >> 4, fr = lane & 15;
    const bf16x8 ones = (fr == 0) ? (bf16x8){0x3F80, 0x3F80, 0x3F80, 0x3F80, 0x3F80, 0x3F80, 0x3F80, 0x3F80} : (bf16x8){0, 0, 0, 0, 0, 0, 0, 0};
    for (int sl = 0; sl < NSL; ++sl) {
        PA_WRITE_V();
        __syncthreads();
        if (sl + 1 < NSL) PA_LOAD_V(sl + 1);
        f32x4 acc[DT][8], accn[DT];
#pragma unroll
        for (int dt = 0; dt < DT; ++dt) { accn[dt] = (f32x4){0.f, 0.f, 0.f, 0.f};
#pragma unroll
            for (int vt = 0; vt < 8; ++vt) acc[dt][vt] = (f32x4){0.f, 0.f, 0.f, 0.f}; }
#pragma unroll
        for (int ks = 0; ks < 4; ++ks) {
            bf16x8 af[DT];
#pragma unroll
            for (int dt = 0; dt < DT; ++dt) af[dt] = tr_frag(kreg, PK, 32 * ks, 16 * (wave * DT + dt), lane);
#pragma unroll
            for (int vt = 0; vt < 8; ++vt) { const bf16x8 bfv = tr_frag(vreg, PV_PITCH, 32 * ks, 16 * vt, lane);
#pragma unroll
                for (int dt = 0; dt < DT; ++dt) acc[dt][vt] = MFMA16(af[dt], bfv, acc[dt][vt]); }
            if (ML && sl == 0) {
#pragma unroll
                for (int dt = 0; dt < DT; ++dt) accn[dt] = MFMA16(af[dt], ones, accn[dt]); }
        }
#pragma unroll
        for (int dt = 0; dt < DT; ++dt) {
            const int d = 16 * (wave * DT + dt) + 4 * g;
#pragma unroll
            for (int vt = 0; vt < 8; ++vt) { const f32x4 a = acc[dt][vt]; v2u o; o.x = pk2(a[0], a[1]); o.y = pk2(a[2], a[3]);
                *(GAS v2u*)(st + (size_t)(128 * sl + 16 * vt + fr) * DK + d) = o; }
            if (ML && sl == 0 && fr == 0) { const f32x4 a = accn[dt]; v2u o; o.x = pk2(a[0], a[1]); o.y = pk2(a[2], a[3]); *(GAS v2u*)(st + (size_t)MDV * DK + d) = o; }
        }
        __syncthreads();
    }
#undef PA_LOAD_V
#undef PA_WRITE_V
}
__device__ __forceinline__ void phaseB(Frame& F) {
    const size_t gt = (size_t)F.vcu * 512 + F.tid, NT = (size_t)F.G * 512;
    for (size_t it = gt; it < (size_t)32 * RDV * 16; it += NT) {
        const int bh = (int)(it >> 12), rem = (int)(it & 4095), v = rem >> 4, dch = rem & 15, h = bh & 7;
        const float decay = __expf(ret_log_gamma(h) * 128.0f);
        bf16* p = (bf16*)(F.ws + WS_ST_R) + ((size_t)bh * NCH * RDV + v) * RDK + 8 * dch;
        float run[8];
#pragma unroll
        for (int e = 0; e < 8; ++e) run[e] = 0.f;
#pragma unroll 16
        for (int c = 0; c < NCH; ++c) { GAS v4u* q = (GAS v4u*)(p + (size_t)c * RDV * RDK); const v4u x = *q;
            v4u o; o.x = pk2(run[0], run[1]); o.y = pk2(run[2], run[3]); o.z = pk2(run[4], run[5]); o.w = pk2(run[6], run[7]); *q = o;
            run[0] = run[0] * decay + bflo(x.x); run[1] = run[1] * decay + bfhi(x.x); run[2] = run[2] * decay + bflo(x.y); run[3] = run[3] * decay + bfhi(x.y);
            run[4] = run[4] * decay + bflo(x.z); run[5] = run[5] * decay + bfhi(x.z); run[6] = run[6] * decay + bflo(x.w); run[7] = run[7] * decay + bfhi(x.w); }
    }
    for (size_t it = gt; it < (size_t)16 * 513 * 32; it += NT) {
        const int bh = (int)(it / (513 * 32)), rem = (int)(it % (513 * 32)), v = rem >> 5, dch = rem & 31;
        bf16* p = (bf16*)(F.ws + WS_ST_M) + ((size_t)bh * NCH * MVR + v) * MDK + 8 * dch;
        const float* chs = (const float*)(F.ws + WS_CHS) + (size_t)bh * NCH * 2; float* mp = (float*)(F.ws + WS_MP) + (size_t)bh * NCH;
        float run[8], m = 0.f;
#pragma unroll
        for (int e = 0; e < 8; ++e) run[e] = 0.f;
#pragma unroll 16
        for (int c = 0; c < NCH; ++c) { GAS v4u* q = (GAS v4u*)(p + (size_t)c * MVR * MDK); const v4u x = *q;
            const float am = chs[2 * c], bl = chs[2 * c + 1], gl = fmaxf(m, am), ws_ = __expf(m - gl), wd = __expf(am - gl);
            if (rem == 0) mp[c] = m;
            v4u o; o.x = pk2(run[0], run[1]); o.y = pk2(run[2], run[3]); o.z = pk2(run[4], run[5]); o.w = pk2(run[6], run[7]); *q = o;
            run[0] = run[0] * ws_ + wd * bflo(x.x); run[1] = run[1] * ws_ + wd * bfhi(x.x); run[2] = run[2] * ws_ + wd * bflo(x.y); run[3] = run[3] * ws_ + wd * bfhi(x.y);
            run[4] = run[4] * ws_ + wd * bflo(x.z); run[5] = run[5] * ws_ + wd * bfhi(x.z); run[6] = run[6] * ws_ + wd * bflo(x.w); run[7] = run[7] * ws_ + wd * bfhi(x.w);
            m = bl + gl; }
    }
}
template <bool ML>
__device__ __forceinline__ void phaseC_unit(Frame& F, int u) {
    constexpr int H = ML ? MH : RH, DK = ML ? MDK : RDK, DV = ML ? MDV : RDV, NSL = DV / 128, KS = DK / 32, VR = ML ? MVR : RDV, PK = ML ? MK_PITCH : PV_PITCH;
    constexpr int KB = 128 * PK * 2, NSTL = (128 * DK * 2) / (512 * 16);
    int tid_ = F.tid; asm volatile("" : "+v"(tid_));
    const int b = u / (H * NCH), h = (u / NCH) % H, c = u % NCH, row0 = b * SEQ + c * CH, tid = tid_, lane = tid & 63, wave = F.wave;
    const bf16* proj = (const bf16*)(F.ws + WS_BIG);
    bf16* mixed = (bf16*)(F.ws + WS_XN);
    LAS unsigned char* kreg = F.lds; LAS unsigned char* qreg = F.lds + KB; LAS unsigned char* vreg = F.lds + KB;
    LAS unsigned char* oreg = F.lds + KB + wave * (16 * PV_PITCH * 2); LAS unsigned char* preg = F.lds + KB + VS_BYTES + wave * (16 * PV_PITCH * 2);
    LAS float* sA = (LAS float*)(F.lds + SM_OFF); LAS float* sB = sA + 128; LAS float* sG = sA + 256; LAS float* sR = sA + 384 + 16 * wave;
    const bf16* st = (const bf16*)(F.ws + (ML ? WS_ST_M : WS_ST_R)) + (size_t)u * VR * DK;
    const int g = lane >> 4, fr = lane & 15, rt = (wave < 4) ? wave : 11 - wave, i = 16 * rt + fr;
    const bf16* vhp = ML ? head_ptr(F.ws, C_MV, MDV, MH, b, h) : head_ptr(F.ws, C_RV, RDV, RH, b, h);
    const bf16* ghp = ML ? head_ptr(F.ws, C_MO, MDV, MH, b, h) : head_ptr(F.ws, C_RG, RDV, RH, b, h);
    float mprev = 0.f;
    const float lg = ML ? 0.f : ret_log_gamma(h);
    if (ML) {
        mprev = ((const float*)(F.ws + WS_MP))[u];
        if (wave == 0) { float amax, blast; gate_scan((const float*)(F.ws + WS_GI), (const float*)(F.ws + WS_LF), row0, h, mprev, sA, sB, sG, amax, blast, lane); }
        stage_conv(kreg, head_ptr(F.ws, C_MK, MDK, MH, b, h), F.in[7], F.in[8], c * CH, 1024 + MDK * h, 0.0625f, nullptr, tid);
        stage_conv(qreg, head_ptr(F.ws, C_MQ, MDK, MH, b, h), F.in[7], F.in[8], c * CH, MDK * h, 1.0f, nullptr, tid);
    } else {
        stage_rot(kreg, head_ptr(F.ws, C_RK, RDK, RH, b, h), (const float*)(F.ws + WS_ROT), c * CH, 0.08838834764831845f, 0.f, tid);
        stage_rot(qreg, head_ptr(F.ws, C_RQ, RDK, RH, b, h), (const float*)(F.ws + WS_ROT), c * CH, 1.0f, 0.f, tid);
    }
    __syncthreads();
    bf16x8 qf[KS];
#pragma unroll
    for (int ks = 0; ks < KS; ++ks) qf[ks] = *(const LAS bf16x8*)(qreg + (i * PK + 32 * ks + 8 * g) * 2);
    float rowscale, gi = 0.f, en = 0.f;
    if (ML) { gi = sG[i]; rowscale = __expf(mprev - gi); en = __expf(-(sB[i] + gi)); }
    else rowscale = __expf(lg * (float)(i + 1));
    __syncthreads();
    v4u vpre[4], spre[NSTL];
#define PC_LOAD_SLICE(sl_) do { \
        _Pragma("unroll") for (int it = 0; it < 4; ++it) { const int p_ = tid + 512 * it, j_ = p_ >> 4, ch_ = p_ & 15; vpre[it] = *(const GAS v4u*)(vhp + (size_t)(c * CH + j_) * DV + 128 * (sl_) + 8 * ch_); } \
        _Pragma("unroll") for (int it = 0; it < NSTL; ++it) { const int p_ = tid + 512 * it, r_ = p_ / (DK / 8), ch_ = p_ % (DK / 8); spre[it] = *(const GAS v4u*)(st + (size_t)(128 * (sl_) + r_) * DK + 8 * ch_); } } while (0)
#define PC_WRITE_SLICE() do { \
        _Pragma("unroll") for (int it = 0; it < 4; ++it) { const int p_ = tid + 512 * it, j_ = p_ >> 4, ch_ = p_ & 15; *(LAS v4u*)(vreg + (j_ * PV_PITCH + 8 * ch_) * 2) = vpre[it]; } \
        _Pragma("unroll") for (int it = 0; it < NSTL; ++it) { const int p_ = tid + 512 * it, r_ = p_ / (DK / 8), ch_ = p_ % (DK / 8); *(LAS v4u*)(kreg + (r_ * PK + 8 * ch_) * 2) = spre[it]; } } while (0)
    PC_LOAD_SLICE(0);
    bf16x8 nvp[ML ? KS : 1];
    if (ML) { const bf16* nrow = st + (size_t)MDV * DK;
#pragma unroll
        for (int ks = 0; ks < KS; ++ks) nvp[ks] = *(const GAS bf16x8*)(nrow + 32 * ks + 8 * g); }
    float rowsum = 0.f;
#pragma unroll
    for (int jt = 0; jt < 8; ++jt) {
        v2u o; o.x = 0u; o.y = 0u;
        if (jt <= rt) {
            f32x4 a = (f32x4){0.f, 0.f, 0.f, 0.f};
#pragma unroll
            for (int ks = 0; ks < KS; ++ks) { const bf16x8 kf = *(const LAS bf16x8*)(kreg + ((16 * jt + fr) * PK + 32 * ks + 8 * g) * 2); a = MFMA16(kf, qf[ks], a); }
            float p[4];
            f32x4 aj = (f32x4){0.f, 0.f, 0.f, 0.f}; if (ML) aj = *(const LAS f32x4*)(sA + 16 * jt + 4 * g);
#pragma unroll
            for (int r = 0; r < 4; ++r) { const int j = 16 * jt + 4 * g + r;
                const float w = ML ? __expf(aj[r] - gi) : __expf(lg * (float)(i - j));
                p[r] = (j <= i) ? a[r] * w : 0.f; rowsum += p[r]; }
            o.x = pk2(p[0], p[1]); o.y = pk2(p[2], p[3]);
        }
        *(LAS v2u*)(preg + (fr * PV_PITCH + 16 * jt + 4 * g) * 2) = o;
    }
    float inv = 1.0f;
    if (ML) {
        rowsum += __shfl_xor(rowsum, 16); rowsum += __shfl_xor(rowsum, 32);
        float qn = 0.f;
#pragma unroll
        for (int ks = 0; ks < KS; ++ks) { const bf16x8 nv = nvp[ks];
#pragma unroll
            for (int e = 0; e < 8; ++e) qn += bf2f(qf[ks][e]) * bf2f(nv[e]); }
        qn += __shfl_xor(qn, 16); qn += __shfl_xor(qn, 32);
        const float nq = rowsum + rowscale * qn;
        inv = 1.0f / fmaxf(fabsf(nq), en);
    }
    const int ocol = ML ? 2048 + MDV * h : RDV * h, gcol = ML ? C_MO + MDV * h : C_RG + RDV * h;
    const int orow0 = row0 + 16 * rt;
    const int lr = lane >> 4, lc = lane & 15;
    float sumsq = 0.f;
    v2u opk[NSL][8];
    v4u gpre[4];
#define PC_LOAD_GATE(sl_) do { _Pragma("unroll") for (int k = 0; k < 4; ++k) gpre[k] = *(const GAS v4u*)(ghp + (size_t)(c * CH + 16 * rt + 4 * k + lr) * DV + 128 * (sl_) + 8 * lc); } while (0)
    __syncthreads();
#pragma unroll
    for (int sl = 0; sl < NSL; ++sl) {
        PC_WRITE_SLICE();
        __syncthreads();
        if (sl + 1 < NSL) PC_LOAD_SLICE(sl + 1);
        else PC_LOAD_GATE(0);
        f32x4 acc[8];
#pragma unroll
        for (int vt = 0; vt < 8; ++vt) { f32x4 a = (f32x4){0.f, 0.f, 0.f, 0.f};
#pragma unroll
            for (int ks = 0; ks < KS; ++ks) { const bf16x8 sf = *(const LAS bf16x8*)(kreg + ((16 * vt + fr) * PK + 32 * ks + 8 * g) * 2); a = MFMA16(sf, qf[ks], a); }
            acc[vt] = a * rowscale;
            if (vt & 1) asm volatile("" ::: "memory"); }
#pragma unroll
        for (int k2 = 0; k2 < 4; ++k2) {
            if (2 * k2 <= rt) {
                const bf16x8 pf = *(const LAS bf16x8*)(preg + (fr * PV_PITCH + 32 * k2 + 8 * g) * 2);
#pragma unroll
                for (int vt = 0; vt < 8; ++vt) { const bf16x8 vf = tr_frag(vreg, PV_PITCH, 32 * k2, 16 * vt, lane); acc[vt] = MFMA16(vf, pf, acc[vt]); } } }
#pragma unroll
        for (int vt = 0; vt < 8; ++vt) { const f32x4 a = acc[vt] * inv; sumsq += (a[0] * a[0] + a[1] * a[1]) + (a[2] * a[2] + a[3] * a[3]);
            opk[sl][vt].x = pk2(a[0], a[1]); opk[sl][vt].y = pk2(a[2], a[3]); }
        __syncthreads();
    }
#undef PC_LOAD_SLICE
#undef PC_WRITE_SLICE
    sumsq += __shfl_xor(sumsq, 16); sumsq += __shfl_xor(sumsq, 32);
    if (g == 0) sR[fr] = 1.0f / sqrtf(sumsq * (1.0f / DV) + NORM_EPS);
    const float* hn = F.in[ML ? 12 : 11] + (ML ? MDV : RDV) * h;
#pragma unroll
    for (int sl = 0; sl < NSL; ++sl) {
#pragma unroll
        for (int vt = 0; vt < 8; ++vt) *(LAS v2u*)(oreg + (fr * PV_PITCH + 16 * vt + 4 * g) * 2) = opk[sl][vt];
        v4u gt[4];
#pragma unroll
        for (int k = 0; k < 4; ++k) gt[k] = gpre[k];
        if (sl + 1 < NSL) PC_LOAD_GATE(sl + 1);
        const f32x4 gn0 = *(const GAS f32x4*)(hn + 128 * sl + 8 * lc), gn1 = *(const GAS f32x4*)(hn + 128 * sl + 8 * lc + 4);
#pragma unroll
        for (int k = 0; k < 4; ++k) { const int r = 4 * k + lr;
            const v4u x = *(const LAS v4u*)(oreg + (r * PV_PITCH + 8 * lc) * 2);
            const float rs = sR[r];
            const float xv[8] = {bflo(x.x), bfhi(x.x), bflo(x.y), bfhi(x.y), bflo(x.z), bfhi(x.z), bflo(x.w), bfhi(x.w)};
            const float gv[8] = {bflo(gt[k].x), bfhi(gt[k].x), bflo(gt[k].y), bfhi(gt[k].y), bflo(gt[k].z), bfhi(gt[k].z), bflo(gt[k].w), bfhi(gt[k].w)};
            const float gnv[8] = {gn0[0], gn0[1], gn0[2], gn0[3], gn1[0], gn1[1], gn1[2], gn1[3]};
            float y[8];
#pragma unroll
            for (int e = 0; e < 8; ++e) { const float sg = __builtin_amdgcn_rcpf(1.0f + __expf(-gv[e])); y[e] = xv[e] * rs * gnv[e] * (ML ? sg : gv[e] * sg); }
            v4u o; o.x = pk2(y[0], y[1]); o.y = pk2(y[2], y[3]); o.z = pk2(y[4], y[5]); o.w = pk2(y[6], y[7]);
            *(GAS v4u*)(mixed + blk_off(orow0 + r, ocol + 128 * sl + 8 * lc, D >> 6)) = o; }
        asm volatile("" ::: "memory");
    }
#undef PC_LOAD_GATE
    __syncthreads();
}
struct Args { const float* in[19]; float* out; unsigned char* ws; };
__global__ void __launch_bounds__(NWAVES * 64, 2) hybrid_fwd(Args args) {
    extern __shared__ __attribute__((aligned(16))) unsigned char lds[];
    Frame F;
    F.lds = (LAS unsigned char*)lds;
    F.MISC = (volatile LAS unsigned*)(F.lds + MISC_OFF);
    F.tid = threadIdx.x; F.lane = F.tid & 63; F.wave = __builtin_amdgcn_readfirstlane(F.tid >> 6);
    F.G = gridDim.x; { const int bx = blockIdx.x; F.vcu = (F.G % 8 == 0) ? (bx % 8) * (F.G / 8) + bx / 8 : bx; }
#pragma unroll
    for (int i = 0; i < 19; ++i) F.in[i] = args.in[i];
    F.out = args.out; F.ws = args.ws;
    unsigned char* ws = args.ws;
    F.ctl = (gu32*)(ws + WS_CTL);
    for (int u = F.tid; u < (LDS_BYTES - LDSCTL_OFF) / 4; u += NWAVES * 64) ((LAS unsigned*)(F.lds + LDSCTL_OFF))[u] = 0u;
    __syncthreads();
    XcdBarrier bar = xcd_barrier_post((unsigned*)(F.ctl + CW_BAR), F.MISC + 8);
#define GRID_BAR() do { xcd_barrier(bar); asm volatile("" : "+v"(F.tid)); F.lane = F.tid & 63; } while (0)
    const int gw = F.vcu * NWAVES + F.wave, NGW = F.G * NWAVES;
    bf16* XN = (bf16*)(ws + WS_XN); bf16* BIG = (bf16*)(ws + WS_BIG); bf16* RES = (bf16*)(ws + WS_RES);
    float dummy[8];

#ifndef PMX_IN
#define PMX_IN 8
#endif
#ifndef PMX_RES
#define PMX_RES 2
#endif
#ifndef SPM_DOWN
#define SPM_DOWN 8
#endif
#ifndef PMX_P2
#define PMX_P2 PMX_RES
#endif
#ifndef PMX_P8
#define PMX_P8 4
#endif
#ifndef PMX_P11
#define PMX_P11 PMX_RES
#endif
#ifndef PHASE_MASK
#define PHASE_MASK 0xFFFF
#endif
#define PH(n) if constexpr ((PHASE_MASK >> (n)) & 1)
    PH(0) {
        LAS float* scr = (LAS float*)(F.lds + RING_OFF + F.wave * 16384);
        constexpr int I_GU = (D / 64) * (FF / 32), I_DN = (FF / 64) * (D / 32), I_IN = (D / 64) * (NPROJ / 32), I_OUT = (D / 64) * (D / 32);
        constexpr int NLATE = 2 * I_DN + I_OUT;
        for (int it = gw; it < NLATE; it += NGW) {
            int r = it;
            if (r < I_DN) { transpose_plain(F.in[4], FF, D, D, (bf16*)(ws + WS_WD1), scr, r, F.lane); continue; } r -= I_DN;
            if (r < I_OUT) { transpose_plain(F.in[13], D, D, D, (bf16*)(ws + WS_WOUT), scr, r, F.lane); continue; } r -= I_OUT;
            transpose_plain8(F.in[17], FF, D, D, ws + WS_WD2, scr, r, F.lane, pg8::F8_W_SCALE);
        }
        const size_t gt = (size_t)F.vcu * 512 + F.tid, NT = (size_t)F.G * 512;
        for (size_t e = gt; e < (size_t)SEQ * 64; e += NT) {
            const int pos = (int)(e >> 6), j = (int)(e & 63);
            double rev = (double)pos * INV_FREQ[j] * 0.15915494309189535; rev -= __builtin_floor(rev);
            const float rf = (float)rev;
            f32x2 cs; cs.x = __builtin_amdgcn_cosf(rf); cs.y = __builtin_amdgcn_sinf(rf);
            ((GAS f32x2*)(ws + WS_ROT))[e] = cs;
        }
        for (size_t e = gt; e < (size_t)8 * D; e += NT) { const int hh = (int)(e >> 12), k = (int)(e & 4095); ((float*)(ws + WS_WG8))[e] = F.in[6][(size_t)k * NPROJ_ALL + NPROJ + hh]; }
        for (int m = gw; m < M; m += NGW) norm_row<0>(F.in[0] + (size_t)m * D, F.in[1], XN, m, nullptr, nullptr, dummy, F.lane);
        for (int it = gw; it < 2 * I_GU; it += NGW) {
            if (it < I_GU) transpose_gu(F.in[2], 0, (bf16*)(ws + WS_WGU1), scr, it, F.lane); else transpose_gu(F.in[3], 1, (bf16*)(ws + WS_WGU1), scr, it - I_GU, F.lane); }
    }
    GRID_BAR();
    PH(1) { pg8::Gemm g{XN, (const bf16*)(ws + WS_WGU1), M, 2 * FF, D}; pg8::StaticOrder S; S.init(M, 2 * FF, F.G, (int)blockIdx.x);
      pg8::EpiSwiGLU E{BIG, FF};
      pg8::gemm_phase<pg8::EpiSwiGLU, pg8::StaticOrder, PG8_ALIGN, PG8_SP2>(F.lds + RING_OFF, g, S, E); }
    GRID_BAR();
    PH(2) { pg8::Gemm g{BIG, (const bf16*)(ws + WS_WD1), M, D, FF}; pg8::Sweep2DOrder<M / 256, SPM_DOWN> S; S.init(M, D, F.G, (int)blockIdx.x);
      pg8::EpiResBf16<true> E{F.in[0], RES, D, 0.5f};
      pg8::gemm_phase<pg8::EpiResBf16<true>, pg8::Sweep2DOrder<M / 256, SPM_DOWN>, PG8_ALIGN, PG8_SP2>(F.lds + RING_OFF, g, S, E); }
    GRID_BAR();
    PH(3) {
        LAS float* wg = (LAS float*)(F.lds + RING_OFF);
        for (int e = F.tid; e < 8 * D / 4; e += NWAVES * 64) ((LAS f32x4*)wg)[e] = ((const GAS f32x4*)(ws + WS_WG8))[e];
        __syncthreads();
        float* GI = (float*)(ws + WS_GI); float* LFp = (float*)(ws + WS_LF);
        for (int m = gw; m < M; m += NGW) {
            float gd[8];
            norm_row_bf<1>(RES + (size_t)m * D, F.in[5], XN, m, nullptr, wg, gd, F.lane);
#pragma unroll
            for (int hh = 0; hh < 8; ++hh) gd[hh] = wave_sum(gd[hh]);
            if (F.lane == 0) {
#pragma unroll
                for (int hh = 0; hh < 4; ++hh) { GI[(size_t)m * 4 + hh] = gd[hh] + F.in[9][hh]; LFp[(size_t)m * 4 + hh] = log_sigmoid(gd[4 + hh] + F.in[10][hh]); }
            }
        }
        __syncthreads();
        {
            LAS float* scr = (LAS float*)(F.lds + RING_OFF + F.wave * 16384);
            constexpr int I_IN = (D / 64) * (NPROJ / 32);
            for (int it = gw; it < I_IN; it += NGW) transpose_plain(F.in[6], D, NPROJ, NPROJ_ALL, (bf16*)(ws + WS_WIN), scr, it, F.lane);
        }
    }
    GRID_BAR();
    PH(4) { pg8::Gemm g{XN, (const bf16*)(ws + WS_WIN), M, NPROJ, D}; pg8::SweepOrder<PMX_IN, M / 256, NPROJ / 256> S; S.init(M, NPROJ, F.G, (int)blockIdx.x);
      pg8::EpiProj E{BIG, M, SEQ};
      pg8::gemm_phase<pg8::EpiProj, pg8::SweepOrder<PMX_IN, M / 256, NPROJ / 256>, PG8_ALIGN, PG8_SP2>(F.lds + RING_OFF, g, S, E); }
    GRID_BAR();
    PH(5) { for (int u = F.vcu; u < BATCH * RH * NCH; u += F.G) phaseA_unit<false>(F, u); }
    PH(13) { for (int u = F.vcu; u < BATCH * MH * NCH; u += F.G) phaseA_unit<true>(F, u); }
    GRID_BAR();
    PH(6) { phaseB(F); }
    GRID_BAR();
    PH(7) { for (int u = F.vcu; u < BATCH * RH * NCH; u += F.G) phaseC_unit<false>(F, u); }
    PH(14) { for (int u = F.vcu; u < BATCH * MH * NCH; u += F.G) phaseC_unit<true>(F, u); }
    GRID_BAR();
    PH(8) { pg8::Gemm g{XN, (const bf16*)(ws + WS_WOUT), M, D, D}; pg8::SweepOrder<PMX_P8, M / 256, D / 256> S; S.init(M, D, F.G, (int)blockIdx.x);
      pg8::EpiResBf16<false> E{RES, RES, D, 1.0f};
      pg8::gemm_phase<pg8::EpiResBf16<false>, pg8::SweepOrder<PMX_P8, M / 256, D / 256>, PG8_ALIGN, PG8_SP2>(F.lds + RING_OFF, g, S, E); }
    GRID_BAR();
    PH(9) {
        for (int m = gw; m < M; m += NGW) norm_row_bf<0, true>(RES + (size_t)m * D, F.in[14], XN, m, nullptr, nullptr, dummy, F.lane, ws + WS_XN8);
        LAS float* scr = (LAS float*)(F.lds + RING_OFF + F.wave * 16384);
        constexpr int I_GU = (D / 64) * (FF / 32);
        for (int it = gw; it < 2 * I_GU; it += NGW) {
            const int half = it >= I_GU, r = it - half * I_GU, kb = r / (FF / 32), n0 = 32 * (r % (FF / 32));
            if (n0 < GU8 * 128) transpose_gu8(F.in[15 + half], half, ws + WS_WGU2, scr, kb, n0, F.lane, pg8::F8_W_SCALE);
            else transpose_gu(F.in[15 + half], half, (bf16*)(ws + WS_WGU2), scr, r, F.lane); }
    }
    GRID_BAR();
    PH(10) {
      { pg8::Gemm g{(const bf16*)(ws + WS_XN8), (const bf16*)(ws + WS_WGU2), M, GU8 * 256, D / 2};     pg8::StaticOrder S; S.init(M, GU8 * 256, F.G, (int)blockIdx.x);
        pg8::EpiSwiGLU8T<true> E{(unsigned char*)BIG, FF, 0, 1.0f / (pg8::F8_X_SCALE * pg8::F8_W_SCALE)};
        pg8::gemm_phase<pg8::EpiSwiGLU8T<true>, pg8::StaticOrder, PG8_ALIGN, PG8_SP2, true>(F.lds + RING_OFF, g, S, E); }
      { pg8::Gemm g{XN, (const bf16*)(ws + WS_WGU2) + (size_t)GU8 * 256 * D, M, 2 * FF - GU8 * 256, D}; pg8::StaticOrder S; S.init(M, 2 * FF - GU8 * 256, F.G, (int)blockIdx.x);
        pg8::EpiSwiGLU8T<false> E{(unsigned char*)BIG, FF, GU8, 1.0f};
        pg8::gemm_phase<pg8::EpiSwiGLU8T<false>, pg8::StaticOrder, PG8_ALIGN, PG8_SP2>(F.lds + RING_OFF, g, S, E); } }
    GRID_BAR();
    PH(11) { pg8::Gemm g{BIG, (const bf16*)(ws + WS_WD2), M, D, FF / 2};     pg8::Sweep2DOrder<M / 256, SPM_DOWN> S; S.init(M, D, F.G, (int)blockIdx.x);
      pg8::EpiResBf16<false> E{RES, RES, D, 0.5f / (pg8::F8_HID_SCALE * pg8::F8_W_SCALE)};
      pg8::gemm_phase<pg8::EpiResBf16<false>, pg8::Sweep2DOrder<M / 256, SPM_DOWN>, PG8_ALIGN, PG8_SP2, true, true>(F.lds + RING_OFF, g, S, E); }
    GRID_BAR();
    PH(12) for (int m = gw; m < M; m += NGW) norm_row_bf<2>(RES + (size_t)m * D, F.in[18], nullptr, 0, F.out + (size_t)m * D, nullptr, dummy, F.lane);
}

extern "C" void kernel_launch(void* const* d_in, const int* in_sizes, int n_in, void* d_out, int out_size, void* d_ws, size_t ws_size, hipStream_t stream) {
    static int grid = 0;
    if (grid == 0) {
        if (n_in != 19 || in_sizes[0] != M * D || out_size != M * D || ws_size < WS_END) { fprintf(stderr, "kernel_launch: unexpected problem: n_in %d in0 %d out %d ws %zu (need %zu); nothing launched\n", n_in, n_in > 0 ? in_sizes[0] : -1, out_size, ws_size, (size_t)WS_END); grid = -1; return; }
        int dev = 0, cus = 0, per_cu = 0;
        if (hipGetDevice(&dev) != hipSuccess || hipDeviceGetAttribute(&cus, hipDeviceAttributeMultiprocessorCount, dev) != hipSuccess) { fprintf(stderr, "kernel_launch: device query failed\n"); grid = -1; return; }
        if (hipFuncSetAttribute((const void*)hybrid_fwd, hipFuncAttributeMaxDynamicSharedMemorySize, LDS_BYTES) != hipSuccess) { fprintf(stderr, "kernel_launch: hipFuncSetAttribute failed\n"); grid = -1; return; }
        if (hipOccupancyMaxActiveBlocksPerMultiprocessor(&per_cu, (const void*)hybrid_fwd, NWAVES * 64, LDS_BYTES) != hipSuccess || per_cu < 1) fprintf(stderr, "kernel_launch: occupancy query reports %d workgroups per CU\n", per_cu);
        (void)hipGetLastError();
        grid = cus;
    }
    if (grid < 0) return;
    if (hipMemsetAsync((char*)d_ws + WS_CTL, 0, CTL_ZERO_BYTES, stream) != hipSuccess) { fprintf(stderr, "kernel_launch: memset failed\n"); return; }
    Args a{};
    for (int i = 0; i < 19; ++i) a.in[i] = (const float*)d_in[i];
    a.out = (float*)d_out; a.ws = (unsigned char*)d_ws;
    hipLaunchKernelGGL(hybrid_fwd, dim3(grid), dim3(NWAVES * 64), LDS_BYTES, stream, a);
    const hipError_t le = hipPeekAtLastError();
    if (le != hipSuccess) fprintf(stderr, "kernel_launch: launch failed: %s\n", hipGetErrorName(le));
}
```
